# Optimizing an MI355X kernel written in HIP

```python
import jax, jax.numpy as jnp
from jax import lax
import numpy as np

D_MODEL = 2048
BATCH = 32
SEQ = 256
DEPTH = 2
DEC_BATCH = 4
DEC_SEQ = 1024
PAST_LEN = 256

GRID_W = 64
N_BRANCH = 4
BRANCH_W = D_MODEL // 2
QK_NOPE = 128
QK_ROPE = 64
V_HEAD = 128
N_HEADS = BRANCH_W // V_HEAD
Q_LORA = 512
KV_LORA = 256
ROPE_BASE = 10000.0
Q_BLOCK = 128
SHORT_K = 3
POOL_WINDOWS = (2, 4, 8, 16)
POOL_GROUPS = 4
POOL_GW = BRANCH_W // POOL_GROUPS
CONF_K = 31
EPS = 1e-6
SEG_SIZES = (Q_LORA, KV_LORA + QK_ROPE, BRANCH_W,
             BRANCH_W, BRANCH_W, BRANCH_W, BRANCH_W,
             BRANCH_W, BRANCH_W,
             2 * BRANCH_W, BRANCH_W,
             N_BRANCH * D_MODEL)
IN_COLS = Q_LORA + KV_LORA + QK_ROPE + 10 * BRANCH_W + N_BRANCH * D_MODEL

kernel_name = "hybrid_mla_conv_pool_conformer_diffusion_step"


def rms_norm(x, w):
    xf = x.astype(jnp.float32)
    y = xf * lax.rsqrt(jnp.mean(xf * xf, axis=-1, keepdims=True) + EPS)
    return (y * w.astype(jnp.float32)).astype(x.dtype)


def layer_norm(x, w, b):
    xf = x.astype(jnp.float32)
    mu = jnp.mean(xf, axis=-1, keepdims=True)
    var = jnp.mean(jnp.square(xf - mu), axis=-1, keepdims=True)
    y = (xf - mu) * lax.rsqrt(var + EPS)
    return (y * w.astype(jnp.float32) + b.astype(jnp.float32)).astype(x.dtype)


def depthwise_conv(x, w, b):
    y = lax.conv_general_dilated(x, w[:, None, :].astype(x.dtype), window_strides=(1,), padding='SAME',
                                 dimension_numbers=('NWC', 'WIO', 'NWC'), feature_group_count=x.shape[-1])
    return y + b.astype(x.dtype)


def grid_rope_tables(n_tokens):
    rows = n_tokens // GRID_W
    r, col = jnp.meshgrid(jnp.arange(rows, dtype=jnp.float32), jnp.arange(GRID_W, dtype=jnp.float32), indexing='ij')
    half = QK_ROPE // 2
    inv = ROPE_BASE ** (-jnp.arange(0, half, 2, dtype=jnp.float32) / half)
    ang = jnp.stack([r.reshape(-1)[:, None] * inv, col.reshape(-1)[:, None] * inv], axis=1)
    return jnp.cos(ang), jnp.sin(ang)


def apply_rope(x, cos, sin):
    xr = x.reshape(x.shape[:-1] + (2, 2, QK_ROPE // 4))
    x1, x2 = xr[..., 0, :], xr[..., 1, :]
    cos = cos.astype(x.dtype)
    sin = sin.astype(x.dtype)
    out = jnp.stack([x1 * cos - x2 * sin, x2 * cos + x1 * sin], axis=-2)
    return out.reshape(x.shape)


def block_attention(q, k, v):
    B, Lq, H, Dk = q.shape
    nb = Lq // Q_BLOCK
    scale = Dk ** -0.5
    qb = q.reshape(B, nb, Q_BLOCK, H, Dk).swapaxes(0, 1)

    def one_block(qblk):
        s = jnp.einsum('bqhd,bkhd->bhqk', qblk, k, preferred_element_type=jnp.float32) * scale
        p = jax.nn.softmax(s, axis=-1).astype(v.dtype)
        return jnp.einsum('bhqk,bkhd->bqhd', p, v)

    o = lax.map(one_block, qb)
    return o.swapaxes(0, 1).reshape(B, Lq, H, v.shape[-1])


def multiscale_pool(xp, pool_w, pool_scale):
    B, L, _ = xp.shape
    xf = xp.astype(jnp.float32)
    cs = jnp.concatenate([jnp.zeros((B, 1, BRANCH_W), jnp.float32), jnp.cumsum(xf, axis=1)], axis=1)
    t = jnp.arange(L)
    groups = []
    for g, w in enumerate(POOL_WINDOWS):
        lo = jnp.clip(t - w // 2, 0, L)
        hi = jnp.clip(t - w // 2 + w, 0, L)
        sl = slice(g * POOL_GW, (g + 1) * POOL_GW)
        csg = cs[..., sl]
        mean = (csg[:, hi] - csg[:, lo]) / (hi - lo).astype(jnp.float32)[None, :, None]
        groups.append(mean - xf[..., sl])
    pooled = jnp.stack(groups, axis=2).astype(xp.dtype)
    y = jnp.einsum('blgc,gcd->blgd', pooled, pool_w).reshape(B, L, BRANCH_W)
    return y * pool_scale


def mixer(h, p, ctx_kv, rope):
    B, L, _ = h.shape
    proj = h @ p['w_in']
    split_pts = [int(s) for s in np.cumsum(SEG_SIZES)[:-1]]
    (q_a, kv_a, g_a, b_gate, c_gate, x_conv, g_b, x_pool, g_c, glu_in, g_d, merge_logits) = jnp.split(proj, split_pts, axis=-1)

    q = (rms_norm(q_a, p['q_norm_w']) @ p['w_qb']).reshape(B, L, N_HEADS, QK_NOPE + QK_ROPE)
    q_nope, q_pe = q[..., :QK_NOPE], q[..., QK_NOPE:]
    c_kv = rms_norm(kv_a[..., :KV_LORA], p['kv_norm_w'])
    k_pe = kv_a[..., KV_LORA:]
    if ctx_kv is None:
        new_kv = jnp.concatenate([c_kv, k_pe], axis=-1)
        kv_all = new_kv
    else:
        cos, sin = rope
        q_pe = apply_rope(q_pe, cos[:, None], sin[:, None])
        k_pe = apply_rope(k_pe, cos, sin)
        kv_all = jnp.concatenate([ctx_kv.astype(h.dtype), jnp.concatenate([c_kv, k_pe], axis=-1)], axis=1)
        new_kv = None
    Lk = kv_all.shape[1]
    kv_up = (kv_all[..., :KV_LORA] @ p['w_kvb']).reshape(B, Lk, N_HEADS, QK_NOPE + V_HEAD)
    k_nope, v = kv_up[..., :QK_NOPE], kv_up[..., QK_NOPE:]
    k_rot = jnp.broadcast_to(kv_all[:, :, None, KV_LORA:], (B, Lk, N_HEADS, QK_ROPE))
    k = jnp.concatenate([k_nope, k_rot], axis=-1)
    qf = jnp.concatenate([q_nope, q_pe], axis=-1)
    y_a = block_attention(qf, k, v).reshape(B, L, N_HEADS * V_HEAD) * jax.nn.silu(g_a)

    y_b = b_gate * depthwise_conv(c_gate * x_conv, p['conv3_w'], p['conv3_b']) * jax.nn.silu(g_b)

    y_c = multiscale_pool(x_pool, p['pool_w'], p['pool_scale']) * jax.nn.silu(g_c)

    u = glu_in[..., :BRANCH_W] * jax.nn.sigmoid(glu_in[..., BRANCH_W:])
    u = jax.nn.silu(layer_norm(depthwise_conv(u, p['dw_w'], p['dw_b']), p['cln_w'], p['cln_b']))
    y_d = u * jax.nn.silu(g_d)

    branches = jnp.stack([y_a, y_b, y_c, y_d], axis=2)
    outs = jnp.einsum('blic,icd->blid', branches, p['w_bproj'])
    gates = jax.nn.sigmoid(merge_logits.reshape(B, L, N_BRANCH, D_MODEL))
    merged = jnp.sum(gates * outs, axis=2)
    return merged @ p['w_out'], new_kv


def setup_inputs(seed: int = 0) -> dict:
    key = jax.random.key(seed)
    ks = jax.random.split(key, 26)
    f32 = jnp.float32
    nrm = lambda k, shape, s: jax.random.normal(k, shape, f32) * s
    D, W = D_MODEL, BRANCH_W
    return {
        'x_prompt': nrm(ks[0], (BATCH, SEQ, D), 1.0),
        'x_sample': nrm(ks[1], (DEC_BATCH, DEC_SEQ, D), 1.0),
        'cache_kv': nrm(ks[2], (DEC_BATCH, DEPTH, PAST_LEN, KV_LORA + QK_ROPE), 1.0),
        'c': nrm(ks[3], (DEC_BATCH, D), 1.0),
        'c_ctx': nrm(ks[4], (D,), 1.0),
        'w_ada': nrm(ks[5], (DEPTH, D, 3 * D), 0.5 * D ** -0.5),
        'b_ada': nrm(ks[6], (DEPTH, 3 * D), 0.02),
        'norm_w': 1.0 + nrm(ks[7], (DEPTH, D), 0.05),
        'w_in': nrm(ks[8], (DEPTH, D, IN_COLS), D ** -0.5),
        'q_norm_w': 1.0 + nrm(ks[9], (DEPTH, Q_LORA), 0.05),
        'w_qb': nrm(ks[10], (DEPTH, Q_LORA, N_HEADS * (QK_NOPE + QK_ROPE)), Q_LORA ** -0.5),
        'kv_norm_w': 1.0 + nrm(ks[11], (DEPTH, KV_LORA), 0.05),
        'w_kvb': nrm(ks[12], (DEPTH, KV_LORA, N_HEADS * (QK_NOPE + V_HEAD)), KV_LORA ** -0.5),
        'conv3_w': nrm(ks[13], (DEPTH, SHORT_K, W), SHORT_K ** -0.5),
        'conv3_b': nrm(ks[14], (DEPTH, W), 0.02),
        'pool_w': nrm(ks[15], (DEPTH, POOL_GROUPS, POOL_GW, POOL_GW), POOL_GW ** -0.5),
        'pool_scale': 1.0 + nrm(ks[16], (DEPTH, W), 0.05),
        'dw_w': nrm(ks[17], (DEPTH, CONF_K, W), CONF_K ** -0.5),
        'dw_b': nrm(ks[18], (DEPTH, W), 0.02),
        'cln_w': 1.0 + nrm(ks[19], (DEPTH, W), 0.05),
        'cln_b': nrm(ks[20], (DEPTH, W), 0.02),
        'w_bproj': nrm(ks[21], (DEPTH, N_BRANCH, W, D), W ** -0.5),
        'w_out': nrm(ks[22], (DEPTH, D, D), D ** -0.5),
        'final_norm_w': 1.0 + nrm(ks[23], (D,), 0.05),
    }


def reference(x_prompt, x_sample, cache_kv, c, c_ctx, w_ada, b_ada, norm_w, w_in, q_norm_w, w_qb,
              kv_norm_w, w_kvb, conv3_w, conv3_b, pool_w, pool_scale, dw_w, dw_b, cln_w, cln_b,
              w_bproj, w_out, final_norm_w):
    def layer_params(l):
        return {'w_in': w_in[l], 'q_norm_w': q_norm_w[l], 'w_qb': w_qb[l], 'kv_norm_w': kv_norm_w[l],
                'w_kvb': w_kvb[l], 'conv3_w': conv3_w[l], 'conv3_b': conv3_b[l], 'pool_w': pool_w[l],
                'pool_scale': pool_scale[l], 'dw_w': dw_w[l], 'dw_b': dw_b[l], 'cln_w': cln_w[l],
                'cln_b': cln_b[l], 'w_bproj': w_bproj[l], 'w_out': w_out[l]}

    y_p = x_prompt
    kv_list = []
    for l in range(DEPTH):
        p = layer_params(l)
        shift, scale, gate = jnp.split(jax.nn.silu(c_ctx) @ w_ada[l] + b_ada[l], 3, axis=-1)
        h = rms_norm(y_p, norm_w[l]) * (1 + scale) + shift
        out, kv = mixer(h, p, None, None)
        y_p = y_p + gate * out
        kv_list.append(kv)
    y_prompt = rms_norm(y_p, final_norm_w)
    new_cache_kv = jnp.stack(kv_list, axis=1)

    rope = grid_rope_tables(x_sample.shape[1])
    y_s = x_sample
    for l in range(DEPTH):
        p = layer_params(l)
        mod = (jax.nn.silu(c) @ w_ada[l] + b_ada[l])[:, None, :]
        shift, scale, gate = jnp.split(mod, 3, axis=-1)
        h = rms_norm(y_s, norm_w[l]) * (1 + scale) + shift
        out, _ = mixer(h, p, cache_kv[:, l], rope)
        y_s = y_s + gate * out
    y_sample = rms_norm(y_s, final_norm_w)
    return (y_prompt, y_sample, new_cache_kv)
```

```cpp
#include <hip/hip_runtime.h>
#include <hip/hip_cooperative_groups.h>
#include <cstdio>
namespace cg = cooperative_groups;

#define LAS __attribute__((address_space(3)))
typedef unsigned short bf16_t;
typedef short bf16x8 __attribute__((ext_vector_type(8)));
typedef float f32x4 __attribute__((ext_vector_type(4)));
typedef float f32x2 __attribute__((ext_vector_type(2)));
typedef unsigned u32x4 __attribute__((ext_vector_type(4)));
typedef unsigned u32x2 __attribute__((ext_vector_type(2)));

constexpr int T = 12288, TC = 8192, DM = 2048, BW = 1024, LDP = 11264, NIN = 19456, KVR = 13312, INC = 19264;
constexpr int C_KVA = 512, C_GA = 896, C_BG = 1920, C_CG = 2944, C_XC = 3968, C_GB = 4992, C_XP = 6016, C_GC = 7040, C_GLU = 8192, C_GD = 10240, C_ML = 11264;
constexpr float EPS = 1e-6f;
constexpr int LDS_XP = 131072 + 16;
constexpr int LDS_BYTES = 131072 + 16 + 8192;
constexpr int NPHASE = 18;

constexpr size_t SZ_WIN1 = (size_t)NIN * 2048 * 2;
constexpr size_t SZ_WBP1 = (size_t)2048 * 4096 * 2;
constexpr size_t SZ_WOUT1 = (size_t)2048 * 2048 * 2;
constexpr size_t SZ_WQB1 = (size_t)1536 * 512 * 2;
constexpr size_t SZ_WK1 = (size_t)1024 * 256 * 2;
constexpr size_t SZ_WPOOL1 = (size_t)4 * 256 * 256 * 2;
constexpr size_t OFF_WIN = 0;
constexpr size_t OFF_WBP = OFF_WIN + 2 * SZ_WIN1;
constexpr size_t OFF_WOUT = OFF_WBP + 2 * SZ_WBP1;
constexpr size_t OFF_WQB = OFF_WOUT + 2 * SZ_WOUT1;
constexpr size_t OFF_WK = OFF_WQB + 2 * SZ_WQB1;
constexpr size_t OFF_WV = OFF_WK + 2 * SZ_WK1;
constexpr size_t OFF_WPOOL = OFF_WV + 2 * SZ_WK1;
constexpr size_t OFF_MOD = OFF_WPOOL + 2 * SZ_WPOOL1;
constexpr size_t OFF_H = OFF_MOD + (size_t)2 * 5 * 6144 * 4;
constexpr size_t OFF_PROJ = OFF_H + (size_t)T * 2048 * 2;
constexpr size_t OFF_QN = OFF_PROJ + (size_t)T * LDP * 2;
constexpr size_t OFF_KVALL = OFF_QN + (size_t)T * 512 * 2;
constexpr size_t OFF_POOLED = OFF_KVALL + (size_t)KVR * 320 * 2;
constexpr size_t OFF_YCAT = OFF_POOLED + (size_t)T * 1024 * 2;
constexpr size_t OFF_Q = OFF_YCAT + (size_t)T * 4096 * 2;
constexpr size_t OFF_KNOPE = OFF_Q + (size_t)T * 1536 * 2;
constexpr size_t OFF_VT = OFF_KNOPE + (size_t)KVR * 1024 * 2;
constexpr size_t OFF_MERGED = OFF_VT + (size_t)KVR * 1024 * 2;
constexpr size_t OFF_XRES = OFF_MERGED + (size_t)T * 2048 * 2;
constexpr size_t OFF_RAT = OFF_XRES + (size_t)T * 2048 * 4;
constexpr size_t OFF_U = OFF_RAT + (size_t)T * 8192 * 2;
constexpr size_t OFF_BAR = OFF_U + (size_t)T * 1024 * 2;
constexpr size_t BAR_BYTES = 16384;
constexpr size_t WS_END = OFF_BAR + BAR_BYTES;

struct Params {
    const float* in[24];
    float* out;
    unsigned char* ws;
    int ph_lo, ph_hi;
};

typedef float f32x2v __attribute__((ext_vector_type(2)));
typedef __bf16 bf16x2v __attribute__((ext_vector_type(2)));
__device__ __forceinline__ unsigned cvt_pk_bf16(float lo, float hi) { const f32x2v v = {lo, hi}; const bf16x2v r = __builtin_convertvector(v, bf16x2v); return __builtin_bit_cast(unsigned, r); }
__device__ __forceinline__ float bf_lo(unsigned u) { return __uint_as_float(u << 16); }
__device__ __forceinline__ float bf_hi(unsigned u) { return __uint_as_float(u & 0xffff0000u); }
__device__ __forceinline__ float siluf(float x) { return x * __builtin_amdgcn_rcpf(1.f + __expf(-x)); }
__device__ __forceinline__ float sigmf(float x) { return __builtin_amdgcn_rcpf(1.f + __expf(-x)); }
template <int O> __device__ __forceinline__ float swz_xor(float v) { return __int_as_float(__builtin_amdgcn_ds_swizzle(__float_as_int(v), (O << 10) | 0x1f)); }
__device__ __forceinline__ float bperm_xor32(float v, int lane) { return __int_as_float(__builtin_amdgcn_ds_bpermute((lane ^ 32) << 2, __float_as_int(v))); }
__device__ __forceinline__ float wave_sum(float v, int lane) {
    v += bperm_xor32(v, lane); v += swz_xor<16>(v); v += swz_xor<8>(v); v += swz_xor<4>(v); v += swz_xor<2>(v); v += swz_xor<1>(v);
    return v;
}
#define UNPACK8(v, f) do { f[0] = bf_lo(v.x); f[1] = bf_hi(v.x); f[2] = bf_lo(v.y); f[3] = bf_hi(v.y); f[4] = bf_lo(v.z); f[5] = bf_hi(v.z); f[6] = bf_lo(v.w); f[7] = bf_hi(v.w); } while (0)
#define PACK8(f, v) do { v.x = cvt_pk_bf16(f[0], f[1]); v.y = cvt_pk_bf16(f[2], f[3]); v.z = cvt_pk_bf16(f[4], f[5]); v.w = cvt_pk_bf16(f[6], f[7]); } while (0)
__device__ __forceinline__ void fma_mix_lo(float& acc, float w, unsigned x) { asm("v_fma_mix_f32 %0, %1, %2, %0 op_sel:[0,0,0] op_sel_hi:[0,1,0]" : "+v"(acc) : "v"(w), "v"(x)); }
__device__ __forceinline__ void fma_mix_hi(float& acc, float w, unsigned x) { asm("v_fma_mix_f32 %0, %1, %2, %0 op_sel:[0,1,0] op_sel_hi:[0,1,0]" : "+v"(acc) : "v"(w), "v"(x)); }
__device__ __forceinline__ float rope_inv(int i) { return __expf(-(float)i * 0.5756462732485114f); }

namespace pg8 {
constexpr int BM = 256, BK = 64, HALF = 128, HTB = HALF * BK * 2, NXCD = 8, WGM = 8;
__device__ __forceinline__ int lds_byte(int r, int c) { const int st = (r >> 4) * 2 + (c >> 5), rr = r & 15, cc = c & 31, ob = rr * 64 + cc * 2; return st * 1024 + (ob ^ (((ob >> 9) & 1) << 5)); }
__device__ __forceinline__ void stage_rc(int b, int& R, int& C) { const int st = b / 1024, sb = b % 1024, swz = sb ^ (((sb >> 9) & 1) << 5); R = (st >> 1) * 16 + swz / 64; C = (st & 1) * 32 + (swz % 64) / 2; }
__device__ __forceinline__ int perm32(int rho) { const int n = rho >> 4, i = rho & 15; return 8 * (i >> 2) + 4 * n + (i & 3); }
struct Unit { int pm, pn; };
struct Gemm { const bf16_t* A; const bf16_t* Bt; int M, N, K, lda, ldb; int a_pn = 0; };
struct StaticOrder {
    int nM, nN, nwg, G, c, pm_off;
    __device__ void init(int M, int N, int G_, int c_, int pm_off_ = 0) { nM = M / BM; nN = N / BM; nwg = nM * nN; G = G_; c = c_; pm_off = pm_off_; }
    __device__ bool next(int i, Unit& u) const {
        const long L = (long)i * G + c; if (L >= nwg) return false;
        int wgid = (int)L; { const int q = nwg / NXCD, r = nwg % NXCD, xcd = wgid % NXCD, off = wgid / NXCD; wgid = (xcd < r ? xcd * (q + 1) : r * (q + 1) + (xcd - r) * q) + off; }
        const int nig = WGM * nN, gid = wgid / nig, fm = gid * WGM, gsz = (nM - fm) < WGM ? (nM - fm) : WGM;
        u.pm = pm_off + fm + ((wgid % nig) % gsz); u.pn = (wgid % nig) / gsz; return true;
    }
};
template <class Epi>
__device__ __forceinline__ void gemm_phase(LAS unsigned char* lds, const Gemm g, const StaticOrder& S, const Epi& E) {
    int tid_ = threadIdx.x; asm volatile("" : "+v"(tid_));
    const int tid = tid_, wid = __builtin_amdgcn_readfirstlane(tid >> 6), lane = tid & 63, wr = wid >> 2, wc = wid & 3, fr = lane & 15, fq = lane >> 4;
    const int K = g.K, nt = K / BK;
    unsigned voffA[2], voffB[2];
#pragma unroll
    for (int i = 0; i < 2; ++i) { int R, C; stage_rc(tid * 16 + i * 8192, R, C); const int Rb = Epi::PERM ? ((R & ~31) + perm32(R & 31)) : R;
        voffA[i] = (unsigned)(R * g.lda + C) * 2u; voffB[i] = (unsigned)(Rb * g.ldb + C) * 2u; }
    const size_t kstep = (size_t)(BK * 2);
    const size_t hstepA = (size_t)HALF * g.lda * 2, hstepB = (size_t)HALF * g.ldb * 2;
    const size_t tstepA = 2 * hstepA, tstepB = 2 * hstepB;
    const unsigned ldsw = (unsigned)wid * 1024u;
    const int aoff = lds_byte(wr * 64 + fr, fq * 8), boff = lds_byte(wc * 32 + fr, fq * 8);
#define PG8_SA(b, h) (((b) * 2 + (h)) * HTB)
#define PG8_SB(b, h) ((4 + (b) * 2 + (h)) * HTB)
#define PG8_STAGE(bufoff, gbase, voff) do { const char* _gb = (const char*)(gbase); asm volatile("" : "+s"(_gb)); _Pragma("unroll") for (int _i = 0; _i < 2; ++_i) \
        __builtin_amdgcn_global_load_lds((const unsigned*)(_gb + (voff)[_i]), (LAS unsigned*)(lds + (bufoff) + ldsw + _i * 8192), 16, 0, 0); } while (0)
#define PG8_LDA(dst, b, h) do { _Pragma("unroll") for (int m = 0; m < 4; ++m) _Pragma("unroll") for (int k = 0; k < 2; ++k) dst[m][k] = *(const LAS bf16x8*)(lds + PG8_SA(b, h) + aoff + m * 2048 + k * 1024); } while (0)
#define PG8_LDB(dst, b, h) do { _Pragma("unroll") for (int n = 0; n < 2; ++n) _Pragma("unroll") for (int k = 0; k < 2; ++k) dst[n][k] = *(const LAS bf16x8*)(lds + PG8_SB(b, h) + boff + n * 2048 + k * 1024); } while (0)
#define PG8_MMA(ai, bj, At, Bt) do { __builtin_amdgcn_s_setprio(1); _Pragma("unroll") for (int m = 0; m < 4; ++m) _Pragma("unroll") for (int n = 0; n < 2; ++n) _Pragma("unroll") for (int k = 0; k < 2; ++k) \
        acc[ai][bj][m][n] = __builtin_amdgcn_mfma_f32_16x16x32_bf16(Bt[n][k], At[m][k], acc[ai][bj][m][n], 0, 0, 0); __builtin_amdgcn_s_setprio(0); } while (0)
#define PG8_WAIT_V(n) asm volatile("s_waitcnt vmcnt(" #n ")" ::: "memory")
#define PG8_WAIT_L(n) asm volatile("s_waitcnt lgkmcnt(" #n ")" ::: "memory")
#define PG8_BAR __builtin_amdgcn_s_barrier()
#define PG8_SCHED __builtin_amdgcn_sched_barrier(0)
    Unit cur, nxt; int ui = 0;
    if (!S.next(0, cur)) return;
    const char* cA = (const char*)g.A + (size_t)cur.pm * tstepA + (size_t)(cur.pn * g.a_pn) * 2; const char* cB = (const char*)g.Bt + (size_t)cur.pn * tstepB;
    PG8_STAGE(PG8_SB(0, 0), cB, voffB); PG8_STAGE(PG8_SA(0, 0), cA, voffA); PG8_STAGE(PG8_SB(0, 1), cB + hstepB, voffB); PG8_STAGE(PG8_SA(0, 1), cA + hstepA, voffA);
    if (wr == 1) PG8_BAR;
    PG8_WAIT_V(4); PG8_BAR;
    PG8_STAGE(PG8_SB(1, 0), cB + kstep, voffB); PG8_STAGE(PG8_SA(1, 0), cA + kstep, voffA); PG8_STAGE(PG8_SB(1, 1), cB + hstepB + kstep, voffB);
    PG8_WAIT_V(6); PG8_BAR;
    f32x4 acc[2][2][4][2];
#pragma unroll
    for (int a = 0; a < 2; ++a)
#pragma unroll
        for (int b = 0; b < 2; ++b)
#pragma unroll
            for (int m = 0; m < 4; ++m)
#pragma unroll
                for (int n = 0; n < 2; ++n) acc[a][b][m][n] = (f32x4){0.f, 0.f, 0.f, 0.f};
    bf16x8 At[4][2], B0[2][2], B1[2][2];
    for (;;) {
        const bool has_next = S.next(ui + 1, nxt);
        const char* nA = has_next ? (const char*)g.A + (size_t)nxt.pm * tstepA + (size_t)(nxt.pn * g.a_pn) * 2 : cA; const char* nB = has_next ? (const char*)g.Bt + (size_t)nxt.pn * tstepB : cB;
        for (int t = 0; t < nt; t += 2) {
            const bool last = (t == nt - 2);
            const char* a1 = cA + (size_t)(t + 1) * kstep;
            const char* a2 = last ? nA : cA + (size_t)(t + 2) * kstep; const char* b2 = last ? nB : cB + (size_t)(t + 2) * kstep;
            const char* a3 = a2 + kstep; const char* b3 = b2 + kstep;
            if constexpr (Epi::MID) { if (t != 0 && (t & 15) == 0) E.mid(acc, cur, t >> 4, wr, wc, fr, fq); }
            PG8_LDB(B0, 0, 0); PG8_SCHED; PG8_LDA(At, 0, 0); PG8_STAGE(PG8_SA(1, 1), a1 + hstepA, voffA);
            PG8_WAIT_L(8); PG8_BAR; PG8_WAIT_L(0); PG8_MMA(0, 0, At, B0); PG8_BAR; PG8_SCHED;
            PG8_LDB(B1, 0, 1); PG8_STAGE(PG8_SB(0, 0), b2, voffB);
            PG8_BAR; PG8_WAIT_L(0); PG8_MMA(0, 1, At, B1); PG8_BAR;
            PG8_LDA(At, 0, 1); PG8_STAGE(PG8_SA(0, 0), a2, voffA);
            PG8_BAR; PG8_WAIT_L(0); PG8_MMA(1, 0, At, B0); PG8_BAR; PG8_SCHED;
            PG8_STAGE(PG8_SB(0, 1), b2 + hstepB, voffB);
            PG8_WAIT_V(6); PG8_BAR; PG8_MMA(1, 1, At, B1); PG8_BAR;
            PG8_LDB(B0, 1, 0); PG8_SCHED; PG8_LDA(At, 1, 0); PG8_STAGE(PG8_SA(0, 1), a2 + hstepA, voffA);
            PG8_WAIT_L(8); PG8_BAR; PG8_WAIT_L(0); PG8_MMA(0, 0, At, B0); PG8_BAR; PG8_SCHED;
            PG8_LDB(B1, 1, 1); PG8_STAGE(PG8_SB(1, 0), b3, voffB);
            PG8_BAR; PG8_WAIT_L(0); PG8_MMA(0, 1, At, B1); PG8_BAR;
            PG8_LDA(At, 1, 1); PG8_STAGE(PG8_SA(1, 0), a3, voffA);
            PG8_BAR; PG8_WAIT_L(0); PG8_MMA(1, 0, At, B0); PG8_BAR; PG8_SCHED;
            PG8_STAGE(PG8_SB(1, 1), b3 + hstepB, voffB);
            PG8_WAIT_V(6); PG8_BAR; PG8_MMA(1, 1, At, B1); PG8_BAR;
        }
        E(acc, cur, wr, wc, fr, fq);
        if (!has_next) break;
#pragma unroll
        for (int a = 0; a < 2; ++a)
#pragma unroll
            for (int b = 0; b < 2; ++b)
#pragma unroll
                for (int m = 0; m < 4; ++m)
#pragma unroll
                    for (int n = 0; n < 2; ++n) acc[a][b][m][n] = (f32x4){0.f, 0.f, 0.f, 0.f};
        cur = nxt; cA = nA; cB = nB; ++ui;
    }
    PG8_WAIT_V(0);
    if (wr == 0) PG8_BAR;
    PG8_BAR;
#undef PG8_SA
#undef PG8_SB
#undef PG8_STAGE
#undef PG8_LDA
#undef PG8_LDB
#undef PG8_MMA
#undef PG8_WAIT_V
#undef PG8_WAIT_L
#undef PG8_BAR
#undef PG8_SCHED
}

struct EpiBf16 {
    static constexpr bool PERM = true, MID = false;
    bf16_t* O; int ldc;
    __device__ __forceinline__ void operator()(f32x4 (&acc)[2][2][4][2], const Unit& u, int wr, int wc, int fr, int fq) const {
        const int row0 = u.pm * BM + wr * 64 + fr, col0 = u.pn * BM + wc * 32 + 8 * fq;
#pragma unroll
        for (int ai = 0; ai < 2; ++ai)
#pragma unroll
            for (int m = 0; m < 4; ++m) { const unsigned ro = (unsigned)(row0 + ai * HALF + m * 16) * (unsigned)ldc + (unsigned)col0;
#pragma unroll
                for (int bj = 0; bj < 2; ++bj) { const f32x4 v0 = acc[ai][bj][m][0], v1 = acc[ai][bj][m][1];
                    u32x4 w; w.x = cvt_pk_bf16(v0[0], v0[1]); w.y = cvt_pk_bf16(v0[2], v0[3]); w.z = cvt_pk_bf16(v1[0], v1[1]); w.w = cvt_pk_bf16(v1[2], v1[3]);
                    *(u32x4*)(O + (ro + bj * HALF)) = w; } }
    }
};
__device__ __forceinline__ float h2f_lo(unsigned u) { return (float)__builtin_bit_cast(_Float16, (unsigned short)(u & 0xffffu)); }
__device__ __forceinline__ float h2f_hi(unsigned u) { return (float)__builtin_bit_cast(_Float16, (unsigned short)(u >> 16)); }
__device__ __forceinline__ unsigned f2h_pk(float a, float b) { return (unsigned)__builtin_bit_cast(unsigned short, (_Float16)a) | ((unsigned)__builtin_bit_cast(unsigned short, (_Float16)b) << 16); }
struct EpiWin {
    static constexpr bool PERM = true, MID = false;
    bf16_t* O; unsigned short* R; bf16_t* U; LAS unsigned* xp;
    __device__ __forceinline__ void operator()(f32x4 (&acc)[2][2][4][2], const Unit& u, int wr, int wc, int fr, int fq) const {
        if (u.pn >= C_GLU / BM && u.pn < C_GD / BM) {
            const int row0g = u.pm * BM + wr * 64 + fr, ch0 = (u.pn - C_GLU / BM) * 128 + wc * 16 + 4 * fq;
#pragma unroll
            for (int ai = 0; ai < 2; ++ai)
#pragma unroll
                for (int m = 0; m < 4; ++m) { const unsigned ro = (unsigned)(row0g + ai * HALF + m * 16) * 1024u + (unsigned)ch0;
#pragma unroll
                    for (int bj = 0; bj < 2; ++bj) { const f32x4 v0 = acc[ai][bj][m][0], v1 = acc[ai][bj][m][1];
                        u32x2 w; w.x = f2h_pk(v0[0] * sigmf(v0[1]), v0[2] * sigmf(v0[3])); w.y = f2h_pk(v1[0] * sigmf(v1[1]), v1[2] * sigmf(v1[3]));
                        *(u32x2*)(U + (ro + bj * 64)) = w; } }
            return; }
        if (u.pn < C_ML / BM) { EpiBf16 e; e.O = O; e.ldc = LDP; e(acc, u, wr, wc, fr, fq); return; }
        LAS unsigned* pad = xp + (wr * 4 + wc) * 256;
        const int row0 = u.pm * BM + wr * 64 + fr, d0 = (u.pn - C_ML / BM) * 64 + wc * 8;
#pragma unroll
        for (int ai = 0; ai < 2; ++ai)
#pragma unroll
            for (int m = 0; m < 4; ++m) { const unsigned ro = (unsigned)(row0 + ai * HALF + m * 16) * 8192u + (unsigned)(d0 + fq * 2048);
#pragma unroll
                for (int bj = 0; bj < 2; ++bj) { float rr[2][4];
#pragma unroll
                    for (int n = 0; n < 2; ++n) { float e[4];
#pragma unroll
                        for (int j = 0; j < 4; ++j) e[j] = 1.f + __expf(-fminf(fmaxf(acc[ai][bj][m][n][j], -30.f), 30.f));
                        rr[n][0] = fminf(e[1] * __builtin_amdgcn_rcpf(e[0]), 60000.f); rr[n][1] = fminf(e[2] * __builtin_amdgcn_rcpf(e[1]), 60000.f);
                        rr[n][2] = fminf(e[3] * __builtin_amdgcn_rcpf(e[2]), 60000.f); rr[n][3] = __builtin_amdgcn_rcpf(e[3]); }
#pragma unroll
                    for (int i = 0; i < 4; ++i) pad[(i * 16 + fr) * 4 + fq] = f2h_pk(rr[0][i], rr[1][i]);
                    asm volatile("s_waitcnt lgkmcnt(0)" ::: "memory");
                    const u32x4 w = *(const LAS u32x4*)(pad + (fq * 16 + fr) * 4);
                    asm volatile("s_waitcnt lgkmcnt(0)" ::: "memory");
                    *(u32x4*)(R + (ro + bj * 32)) = w; } }
    }
};
struct EpiPool {
    static constexpr bool PERM = true, MID = false;
    bf16_t* O; const float* scale; const bf16_t* gc;
    __device__ __forceinline__ void operator()(f32x4 (&acc)[2][2][4][2], const Unit& u, int wr, int wc, int fr, int fq) const {
        const int row0 = u.pm * BM + wr * 64 + fr, col0 = u.pn * BM + wc * 32 + 8 * fq;
#pragma unroll
        for (int bj = 0; bj < 2; ++bj) {
            const f32x4 s0 = *(const f32x4*)(scale + col0 + bj * HALF), s1 = *(const f32x4*)(scale + col0 + bj * HALF + 4);
            u32x4 gv[2][4];
#pragma unroll
            for (int ai = 0; ai < 2; ++ai)
#pragma unroll
                for (int m = 0; m < 4; ++m) gv[ai][m] = *(const u32x4*)(gc + ((unsigned)(row0 + ai * HALF + m * 16) * (unsigned)LDP + col0 + bj * HALF));
#pragma unroll
            for (int ai = 0; ai < 2; ++ai)
#pragma unroll
                for (int m = 0; m < 4; ++m) { const unsigned r = (unsigned)(row0 + ai * HALF + m * 16);
                    float gf[8]; UNPACK8(gv[ai][m], gf);
                    const f32x4 v0 = acc[ai][bj][m][0] * s0, v1 = acc[ai][bj][m][1] * s1;
                    u32x4 w;
                    w.x = cvt_pk_bf16(v0[0] * siluf(gf[0]), v0[1] * siluf(gf[1])); w.y = cvt_pk_bf16(v0[2] * siluf(gf[2]), v0[3] * siluf(gf[3]));
                    w.z = cvt_pk_bf16(v1[0] * siluf(gf[4]), v1[1] * siluf(gf[5])); w.w = cvt_pk_bf16(v1[2] * siluf(gf[6]), v1[3] * siluf(gf[7]));
                    *(u32x4*)(O + (r * 4096u + col0 + bj * HALF)) = w; }
            asm volatile("" ::: "memory"); }
    }
};
struct EpiRes {
    static constexpr bool PERM = false, MID = false;
    const float* xin0; const float* xin1; float* xo; const float* modl;
    __device__ __forceinline__ void operator()(f32x4 (&acc)[2][2][4][2], const Unit& u, int wr, int wc, int fr, int fq) const {
        const int row0 = u.pm * BM + wr * 64 + fr, col0 = u.pn * BM + wc * 32 + 4 * fq;
        const int ci = u.pm < 32 ? 0 : 1 + ((u.pm - 32) >> 2);
        const float* gate = modl + ci * 6144 + 4096;
        const float* xin = u.pm < 32 ? xin0 : xin1;
        f32x4 gv[2][2];
#pragma unroll
        for (int bj = 0; bj < 2; ++bj)
#pragma unroll
            for (int n = 0; n < 2; ++n) gv[bj][n] = *(const f32x4*)(gate + col0 + bj * HALF + n * 16);
#pragma unroll
        for (int ai = 0; ai < 2; ++ai) {
            f32x4 xv[4][2][2];
#pragma unroll
            for (int m = 0; m < 4; ++m)
#pragma unroll
                for (int bj = 0; bj < 2; ++bj)
#pragma unroll
                    for (int n = 0; n < 2; ++n) xv[m][bj][n] = *(const f32x4*)(xin + ((unsigned)(row0 + ai * HALF + m * 16) * 2048u + (unsigned)col0 + bj * HALF + n * 16));
#pragma unroll
            for (int m = 0; m < 4; ++m)
#pragma unroll
                for (int bj = 0; bj < 2; ++bj)
#pragma unroll
                    for (int n = 0; n < 2; ++n) *(f32x4*)(xo + ((unsigned)(row0 + ai * HALF + m * 16) * 2048u + (unsigned)col0 + bj * HALF + n * 16)) = xv[m][bj][n] + gv[bj][n] * acc[ai][bj][m][n];
            asm volatile("" ::: "memory"); }
    }
};
struct EpiMerge {
    static constexpr bool PERM = true, MID = true;
    const unsigned short* R; bf16_t* O;
    __device__ __forceinline__ void scale(f32x4 (&acc)[2][2][4][2], const Unit& u, int i, int wr, int wc, int fr, int fq) const {
        const int row0 = u.pm * BM + wr * 64 + fr, col0 = u.pn * BM + wc * 32 + 8 * fq;
        u32x4 av[2][4][2];
#pragma unroll
        for (int ai = 0; ai < 2; ++ai)
#pragma unroll
            for (int m = 0; m < 4; ++m)
#pragma unroll
                for (int bj = 0; bj < 2; ++bj) av[ai][m][bj] = *(const u32x4*)(R + ((unsigned)(row0 + ai * HALF + m * 16) * 8192u + (unsigned)(i * 2048 + col0 + bj * HALF)));
#pragma unroll
        for (int ai = 0; ai < 2; ++ai)
#pragma unroll
            for (int m = 0; m < 4; ++m)
#pragma unroll
                for (int bj = 0; bj < 2; ++bj) { const u32x4 v = av[ai][m][bj];
                    acc[ai][bj][m][0][0] *= h2f_lo(v.x); acc[ai][bj][m][0][1] *= h2f_hi(v.x); acc[ai][bj][m][0][2] *= h2f_lo(v.y); acc[ai][bj][m][0][3] *= h2f_hi(v.y);
                    acc[ai][bj][m][1][0] *= h2f_lo(v.z); acc[ai][bj][m][1][1] *= h2f_hi(v.z); acc[ai][bj][m][1][2] *= h2f_lo(v.w); acc[ai][bj][m][1][3] *= h2f_hi(v.w); }
        asm volatile("" ::: "memory");
    }
    __device__ __forceinline__ void mid(f32x4 (&acc)[2][2][4][2], const Unit& u, int tb, int wr, int wc, int fr, int fq) const { scale(acc, u, tb - 1, wr, wc, fr, fq); }
    __device__ __forceinline__ void operator()(f32x4 (&acc)[2][2][4][2], const Unit& u, int wr, int wc, int fr, int fq) const {
        scale(acc, u, 3, wr, wc, fr, fq);
        EpiBf16 e; e.O = O; e.ldc = 2048; e(acc, u, wr, wc, fr, fq);
    }
};
}

__device__ __forceinline__ void conv_jobs(const Params& p, unsigned char* shm, int job_lo, int job_hi, int nb, int bidx) {
    int tid_ = threadIdx.x; asm volatile("" : "+v"(tid_));
    const int tid = tid_, wid = tid >> 6, lane = tid & 63, G = nb;
    unsigned* L = (unsigned*)shm + wid * (64 * 33);
    int ubase = 0;
    for (int job = job_lo; job < job_hi; ++job) {
        const int l = job / 13, jj = job % 13;
        const float* src; int src_ld, dst_ld, N, K, mode = 0; bf16_t* dst;
        if (jj == 0) { src = p.in[8] + (size_t)l * 2048 * INC; src_ld = INC; dst = (bf16_t*)(p.ws + OFF_WIN + l * SZ_WIN1); dst_ld = 2048; N = NIN; K = 2048; mode = 1; }
        else if (jj <= 4) { const int i = jj - 1; src = p.in[21] + (size_t)(l * 4 + i) * 1024 * 2048; src_ld = 2048; dst = (bf16_t*)(p.ws + OFF_WBP + l * SZ_WBP1) + i * 1024; dst_ld = 4096; N = 2048; K = 1024; }
        else if (jj == 5) { src = p.in[22] + (size_t)l * 2048 * 2048; src_ld = 2048; dst = (bf16_t*)(p.ws + OFF_WOUT + l * SZ_WOUT1); dst_ld = 2048; N = 2048; K = 2048; }
        else if (jj == 6) { src = p.in[10] + (size_t)l * 512 * 1536; src_ld = 1536; dst = (bf16_t*)(p.ws + OFF_WQB + l * SZ_WQB1); dst_ld = 512; N = 1536; K = 512; }
        else if (jj == 7) { src = p.in[12] + (size_t)l * 256 * 2048; src_ld = 2048; dst = (bf16_t*)(p.ws + OFF_WK + l * SZ_WK1); dst_ld = 256; N = 1024; K = 256; mode = 2; }
        else if (jj == 8) { src = p.in[12] + (size_t)l * 256 * 2048; src_ld = 2048; dst = (bf16_t*)(p.ws + OFF_WV + l * SZ_WK1); dst_ld = 256; N = 1024; K = 256; mode = 3; }
        else { const int g = jj - 9; src = p.in[15] + (size_t)(l * 4 + g) * 256 * 256; src_ld = 256; dst = (bf16_t*)(p.ws + OFF_WPOOL + l * SZ_WPOOL1) + (size_t)g * 256 * 256; dst_ld = 256; N = 256; K = 256; }
        const int nkt = K >> 6, nunits = ((N >> 6) * nkt) >> 3;
        int first = (bidx - ubase) % G; if (first < 0) first += G;
        for (int u = first; u < nunits; u += G) {
            const int tile = u * 8 + wid, nt = tile / nkt, kt = tile - nt * nkt, n0 = nt * 64, k0 = kt * 64;
            int sc = n0;
            if (mode == 1) sc = n0 < 832 ? n0 : (n0 < 896 ? -1 : (n0 < 8064 ? n0 - 64 : (n0 < C_GLU ? -1 : (n0 < C_GD ? -3 : (n0 < C_ML ? n0 - 192 : -2)))));
            else if (mode == 2) sc = (n0 >> 7) * 256 + (n0 & 127);
            else if (mode == 3) sc = (n0 >> 7) * 256 + 128 + (n0 & 127);
            const int c4 = lane & 15, r = lane >> 4;
            if (sc == -2) {
                const unsigned o0 = (unsigned)(k0 + 2 * r) * (unsigned)src_ld + 11072u + (unsigned)(((n0 - C_ML) >> 2) + c4);
#pragma unroll
                for (int hf = 0; hf < 2; ++hf) {
                    float xa[4][4], xb[4][4];
#pragma unroll
                    for (int i2 = 0; i2 < 4; ++i2)
#pragma unroll
                        for (int j = 0; j < 4; ++j) { const int it = hf * 4 + i2; xa[i2][j] = src[o0 + (unsigned)(it * 8) * (unsigned)src_ld + j * 2048u]; xb[i2][j] = src[o0 + (unsigned)(it * 8 + 1) * (unsigned)src_ld + j * 2048u]; }
#pragma unroll
                    for (int i2 = 0; i2 < 4; ++i2)
#pragma unroll
                        for (int j = 0; j < 4; ++j) L[(4 * c4 + j) * 33 + (hf * 4 + i2) * 4 + r] = cvt_pk_bf16(xa[i2][j], xb[i2][j]);
                    asm volatile("" ::: "memory"); }
            } else if (sc == -3) {
                const unsigned o0 = (unsigned)(k0 + 2 * r) * (unsigned)src_ld + 8000u + (unsigned)(((n0 - C_GLU) >> 1) + 2 * c4);
#pragma unroll
                for (int hf = 0; hf < 2; ++hf) {
                    float xa[4][4], xb[4][4];
#pragma unroll
                    for (int i2 = 0; i2 < 4; ++i2)
#pragma unroll
                        for (int j = 0; j < 4; ++j) { const int it = hf * 4 + i2; const unsigned oc = (unsigned)((j & 1) * 1024 + (j >> 1));
                            xa[i2][j] = src[o0 + (unsigned)(it * 8) * (unsigned)src_ld + oc]; xb[i2][j] = src[o0 + (unsigned)(it * 8 + 1) * (unsigned)src_ld + oc]; }
#pragma unroll
                    for (int i2 = 0; i2 < 4; ++i2)
#pragma unroll
                        for (int j = 0; j < 4; ++j) L[(4 * c4 + j) * 33 + (hf * 4 + i2) * 4 + r] = cvt_pk_bf16(xa[i2][j], xb[i2][j]);
                    asm volatile("" ::: "memory"); }
            } else {
            f32x4 va[8], vb[8];
            if (sc >= 0) { const float* sp = src + (size_t)(k0 + 2 * r) * src_ld + sc + 4 * c4;
#pragma unroll
                for (int it = 0; it < 8; ++it) { va[it] = *(const f32x4*)(sp + (size_t)(it * 8) * src_ld); vb[it] = *(const f32x4*)(sp + (size_t)(it * 8 + 1) * src_ld); } }
            else {
#pragma unroll
                for (int it = 0; it < 8; ++it) { va[it] = (f32x4){0.f, 0.f, 0.f, 0.f}; vb[it] = (f32x4){0.f, 0.f, 0.f, 0.f}; } }
#pragma unroll
            for (int it = 0; it < 8; ++it)
#pragma unroll
                for (int j = 0; j < 4; ++j) L[(4 * c4 + j) * 33 + it * 4 + r] = cvt_pk_bf16(va[it][j], vb[it][j]);
            }
            __syncthreads();
#pragma unroll
            for (int ps = 0; ps < 8; ++ps) { const int n = ps * 8 + (lane >> 3), kw = (lane & 7) * 4;
                u32x4 o; o.x = L[n * 33 + kw]; o.y = L[n * 33 + kw + 1]; o.z = L[n * 33 + kw + 2]; o.w = L[n * 33 + kw + 3];
                *(u32x4*)(dst + (size_t)(n0 + n) * dst_ld + k0 + kw * 2) = o; }
            __syncthreads();
        }
        ubase = (ubase + nunits) % G;
    }
}

__device__ __forceinline__ void phase_prep(const Params& p, unsigned char* shm) {
    int tid_ = threadIdx.x; asm volatile("" : "+v"(tid_));
    const int tid = tid_, wid = tid >> 6, lane = tid & 63, G = gridDim.x;
    const float* c = p.in[3]; const float* c_ctx = p.in[4]; const float* w_ada = p.in[5]; const float* b_ada = p.in[6];
    float* mod = (float*)(p.ws + OFF_MOD);
    for (int u = blockIdx.x; u < 256; u += G) {
        const int l = u >> 7, cc = u & 127;
        float* s = (float*)shm;
        for (int i = tid; i < 5 * 2048; i += 512) { const int ci = i >> 11, k = i & 2047; const float v = ci == 0 ? c_ctx[k] : c[(ci - 1) * 2048 + k]; s[i] = v / (1.f + expf(-v)); }
        __syncthreads();
        const float* w = w_ada + (size_t)l * 2048 * 6144 + cc * 48 + (lane < 48 ? lane : 47);
        float a0 = 0.f, a1 = 0.f, a2 = 0.f, a3 = 0.f, a4 = 0.f;
        const int kb = wid * 256;
#pragma unroll 32
        for (int k = kb; k < kb + 256; ++k) { const float wv = w[(size_t)k * 6144]; a0 += s[k] * wv; a1 += s[2048 + k] * wv; a2 += s[4096 + k] * wv; a3 += s[6144 + k] * wv; a4 += s[8192 + k] * wv; }
        float* red = (float*)(shm + 40960);
        red[(wid * 5 + 0) * 64 + lane] = a0; red[(wid * 5 + 1) * 64 + lane] = a1; red[(wid * 5 + 2) * 64 + lane] = a2; red[(wid * 5 + 3) * 64 + lane] = a3; red[(wid * 5 + 4) * 64 + lane] = a4;
        __syncthreads();
        if (tid < 320) { const int ci = tid >> 6; float r = 0.f;
#pragma unroll
            for (int w8 = 0; w8 < 8; ++w8) r += red[(w8 * 5 + ci) * 64 + lane];
            const int col = cc * 48 + lane; if (lane < 48) mod[(size_t)(l * 5 + ci) * 6144 + col] = r + b_ada[l * 6144 + col]; }
        __syncthreads();
    }
    conv_jobs(p, shm, 0, 1, G, blockIdx.x);
}

__device__ __forceinline__ void phase_norm(const Params& p, int l, int r_lo, int r_hi, int nb, int bidx) {
    int tid_ = threadIdx.x; asm volatile("" : "+v"(tid_));
    const int tid = tid_, wid = tid >> 6, lane = tid & 63, G = gridDim.x;
    const float* nw = p.in[7] + l * 2048;
    const float* mod = (const float*)(p.ws + OFF_MOD);
    const float* xres = (const float*)(p.ws + OFF_XRES);
    bf16_t* h = (bf16_t*)(p.ws + OFF_H);
    for (int r = r_lo + bidx * 8 + wid; r < r_hi; r += nb * 8) {
        const float* x = l == 0 ? (r < TC ? p.in[0] + (size_t)r * 2048 : p.in[1] + (size_t)(r - TC) * 2048) : xres + (size_t)r * 2048;
        const int ci = r < TC ? 0 : 1 + ((r - TC) >> 10);
        const float* md = mod + (size_t)(l * 5 + ci) * 6144;
        f32x4 v[8]; float ss = 0.f;
#pragma unroll
        for (int j = 0; j < 8; ++j) { v[j] = *(const f32x4*)(x + j * 256 + lane * 4); ss += v[j][0] * v[j][0] + v[j][1] * v[j][1] + v[j][2] * v[j][2] + v[j][3] * v[j][3]; }
        ss = wave_sum(ss, lane);
        const float rstd = 1.f / sqrtf(ss * (1.f / 2048.f) + EPS);
#pragma unroll
        for (int j = 0; j < 8; ++j) { const int cix = j * 256 + lane * 4;
            const f32x4 w4 = *(const f32x4*)(nw + cix), sh = *(const f32x4*)(md + cix), sc = *(const f32x4*)(md + 2048 + cix);
            const f32x4 y = v[j] * rstd * w4 * (sc + 1.f) + sh;
            u32x2 o; o.x = cvt_pk_bf16(y[0], y[1]); o.y = cvt_pk_bf16(y[2], y[3]);
            *(u32x2*)(h + (size_t)r * 2048 + cix) = o; }
    }
}

__device__ __forceinline__ void phase_final(const Params& p, int r_lo, int r_hi, int nb, int bidx) {
    int tid_ = threadIdx.x; asm volatile("" : "+v"(tid_));
    const int tid = tid_, wid = tid >> 6, lane = tid & 63, G = gridDim.x;
    const float* fw = p.in[23];
    const float* xres = (const float*)(p.ws + OFF_XRES);
    for (int r = r_lo + bidx * 8 + wid; r < r_hi; r += nb * 8) {
        const float* x = xres + (size_t)r * 2048;
        f32x4 v[8]; float ss = 0.f;
#pragma unroll
        for (int j = 0; j < 8; ++j) { v[j] = *(const f32x4*)(x + j * 256 + lane * 4); ss += v[j][0] * v[j][0] + v[j][1] * v[j][1] + v[j][2] * v[j][2] + v[j][3] * v[j][3]; }
        ss = wave_sum(ss, lane);
        const float rstd = 1.f / sqrtf(ss * (1.f / 2048.f) + EPS);
#pragma unroll
        for (int j = 0; j < 8; ++j) { const int cix = j * 256 + lane * 4; const f32x4 w4 = *(const f32x4*)(fw + cix);
            *(f32x4*)(p.out + (size_t)r * 2048 + cix) = v[j] * rstd * w4; }
    }
}

__device__ __forceinline__ void phase_elem(const Params& p, int l, unsigned char* shm) {
    int tid_ = threadIdx.x; asm volatile("" : "+v"(tid_));
    const int tid = tid_, wid = tid >> 6, lane = tid & 63, G = gridDim.x;
    const bf16_t* proj = (const bf16_t*)(p.ws + OFF_PROJ);
    bf16_t* qn = (bf16_t*)(p.ws + OFF_QN);
    bf16_t* kvall = (bf16_t*)(p.ws + OFF_KVALL);
    bf16_t* pooled = (bf16_t*)(p.ws + OFF_POOLED);
    bf16_t* ycat = (bf16_t*)(p.ws + OFF_YCAT);
    float* outc = p.out + (size_t)T * 2048;
    const bf16_t* ug = (const bf16_t*)(p.ws + OFF_U);
    { const float* cache = p.in[2];
      for (int i = blockIdx.x * 512 + tid; i < 4 * 256 * 320; i += G * 512) { const int j = i / (256 * 320), rem = i % (256 * 320), s = rem / 320, cc = rem % 320;
          const float v = cache[((size_t)(j * 2 + l) * 256 + s) * 320 + cc]; kvall[(size_t)(TC + j * 1280 + s) * 320 + cc] = (bf16_t)(cvt_pk_bf16(v, 0.f) & 0xffffu); } }
    const float* qnw = p.in[9] + l * 512; const float* kvnw = p.in[11] + l * 256;
    const float* c3w = p.in[13] + l * 3 * 1024; const float* c3b = p.in[14] + l * 1024;
    const float* dww = p.in[17] + l * 31 * 1024; const float* dwb = p.in[18] + l * 1024;
    const float* clw = p.in[19] + l * 1024; const float* clb = p.in[20] + l * 1024;
    for (int tile = blockIdx.x; tile < 768; tile += G) {
        const int t0 = tile * 16; const bool lat = t0 >= TC;
        const int s0 = lat ? TC + ((t0 - TC) & ~1023) : (t0 & ~255), s1 = s0 + (lat ? 1024 : 256);
#pragma unroll
        for (int i = 0; i < 2; ++i) {
            const int t = t0 + wid * 2 + i; const bf16_t* pr = proj + (size_t)t * LDP;
            { const u32x4 qv = *(const u32x4*)(pr + lane * 8); float f[8]; UNPACK8(qv, f);
              float ss = 0.f;
#pragma unroll
              for (int e = 0; e < 8; ++e) ss += f[e] * f[e];
              ss = wave_sum(ss, lane); const float rstd = 1.f / sqrtf(ss * (1.f / 512.f) + EPS);
              const f32x4 wa = *(const f32x4*)(qnw + lane * 8), wb = *(const f32x4*)(qnw + lane * 8 + 4);
              float o[8];
#pragma unroll
              for (int e = 0; e < 4; ++e) { o[e] = f[e] * rstd * wa[e]; o[4 + e] = f[4 + e] * rstd * wb[e]; }
              u32x4 w; PACK8(o, w); *(u32x4*)(qn + (size_t)t * 512 + lane * 8) = w; }
            { u32x4 kv = (u32x4){0u, 0u, 0u, 0u}; if (lane < 40) kv = *(const u32x4*)(pr + C_KVA + lane * 8);
              float g[8]; UNPACK8(kv, g);
              float ss = 0.f;
              if (lane < 32) {
#pragma unroll
                  for (int e = 0; e < 8; ++e) ss += g[e] * g[e]; }
              ss = wave_sum(ss, lane); const float rstd = 1.f / sqrtf(ss * (1.f / 256.f) + EPS);
              float pv[8];
#pragma unroll
              for (int e = 0; e < 8; ++e) pv[e] = swz_xor<2>(g[e]);
              float o[8];
              if (lane < 32) { const f32x4 wa = *(const f32x4*)(kvnw + lane * 8), wb = *(const f32x4*)(kvnw + lane * 8 + 4);
#pragma unroll
                  for (int e = 0; e < 4; ++e) { o[e] = g[e] * rstd * wa[e]; o[4 + e] = g[4 + e] * rstd * wb[e]; } }
              else if (lat && lane < 40) { const int q = lane - 32, tl = t - s0, axis = q >> 2, ib = (q & 1) * 8; const bool second = (q & 2) != 0;
                  const float pos = (float)(axis ? (tl & 63) : (tl >> 6));
#pragma unroll
                  for (int e = 0; e < 8; ++e) { const float ang = pos * rope_inv(ib + e); const float sn = __sinf(ang), cs = __cosf(ang);
                      o[e] = second ? g[e] * cs + pv[e] * sn : g[e] * cs - pv[e] * sn; } }
              else {
#pragma unroll
                  for (int e = 0; e < 8; ++e) o[e] = g[e]; }
              if (lane < 40) {
                  const int row = lat ? TC + ((t - TC) >> 10) * 1280 + 256 + (t - s0) : t;
                  u32x4 w; PACK8(o, w); *(u32x4*)(kvall + (size_t)row * 320 + lane * 8) = w;
                  if (!lat) { const int b = t >> 8, s = t & 255; float* oc = outc + ((size_t)(b * 2 + l) * 256 + s) * 320 + lane * 8;
                      *(f32x4*)oc = (f32x4){o[0], o[1], o[2], o[3]}; *(f32x4*)(oc + 4) = (f32x4){o[4], o[5], o[6], o[7]}; } } }
        }
        { const int cg8 = tid & 127, rsub = tid >> 7, c0 = cg8 * 8;
          float w0[8], w1[8], w2[8], bb[8];
#pragma unroll
          for (int e = 0; e < 8; ++e) { w0[e] = c3w[c0 + e]; w1[e] = c3w[1024 + c0 + e]; w2[e] = c3w[2048 + c0 + e]; bb[e] = c3b[c0 + e]; }
          const int grp = cg8 >> 5, win = 2 << grp;
#pragma unroll
          for (int ps = 0; ps < 8; ++ps) { const int rr = ps * 4 + rsub, t = t0 - 8 + rr; u32x4 o = (u32x4){0u, 0u, 0u, 0u};
              if (t >= s0 && t < s1) o = *(const u32x4*)(proj + (size_t)t * LDP + C_XP + c0);
              *(u32x4*)(shm + rr * 2048 + c0 * 2) = o; }
          __syncthreads();
#pragma unroll
          for (int ps = 0; ps < 4; ++ps) {
              const int t = t0 + ps * 4 + rsub; const bf16_t* pr = proj + (size_t)t * LDP;
              float pm[8], p0[8], pp[8];
              { const u32x4 a = *(const u32x4*)(pr + C_CG + c0), b = *(const u32x4*)(pr + C_XC + c0); float fa[8], fb[8]; UNPACK8(a, fa); UNPACK8(b, fb);
#pragma unroll
                for (int e = 0; e < 8; ++e) p0[e] = fa[e] * fb[e]; }
              if (t - 1 >= s0) { const u32x4 a = *(const u32x4*)(pr - LDP + C_CG + c0), b = *(const u32x4*)(pr - LDP + C_XC + c0); float fa[8], fb[8]; UNPACK8(a, fa); UNPACK8(b, fb);
#pragma unroll
                for (int e = 0; e < 8; ++e) pm[e] = fa[e] * fb[e]; }
              else {
#pragma unroll
                for (int e = 0; e < 8; ++e) pm[e] = 0.f; }
              if (t + 1 < s1) { const u32x4 a = *(const u32x4*)(pr + LDP + C_CG + c0), b = *(const u32x4*)(pr + LDP + C_XC + c0); float fa[8], fb[8]; UNPACK8(a, fa); UNPACK8(b, fb);
#pragma unroll
                for (int e = 0; e < 8; ++e) pp[e] = fa[e] * fb[e]; }
              else {
#pragma unroll
                for (int e = 0; e < 8; ++e) pp[e] = 0.f; }
              { const u32x4 a = *(const u32x4*)(pr + C_BG + c0), b = *(const u32x4*)(pr + C_GB + c0); float fa[8], fb[8]; UNPACK8(a, fa); UNPACK8(b, fb);
                float o[8];
#pragma unroll
                for (int e = 0; e < 8; ++e) o[e] = fa[e] * (w0[e] * pm[e] + w1[e] * p0[e] + w2[e] * pp[e] + bb[e]) * siluf(fb[e]);
                u32x4 w; PACK8(o, w); *(u32x4*)(ycat + (size_t)t * 4096 + 1024 + c0) = w; }
              { int lo = t - (win >> 1), hi = lo + win; const int lrow = t - t0 + 8 - (win >> 1); lo = lo < s0 ? s0 : lo; hi = hi > s1 ? s1 : hi;
                float sm[8];
#pragma unroll
                for (int e = 0; e < 8; ++e) sm[e] = 0.f;
#pragma unroll 4
                for (int j = 0; j < win; ++j) { const u32x4 a = *(const u32x4*)(shm + (lrow + j) * 2048 + c0 * 2); float fa[8]; UNPACK8(a, fa);
#pragma unroll
                    for (int e = 0; e < 8; ++e) sm[e] += fa[e]; }
                const u32x4 a = *(const u32x4*)(shm + (t - t0 + 8) * 2048 + c0 * 2); float fa[8]; UNPACK8(a, fa);
                const float inv = 1.f / (float)(hi - lo);
                float o[8];
#pragma unroll
                for (int e = 0; e < 8; ++e) o[e] = sm[e] * inv - fa[e];
                u32x4 w; PACK8(o, w); *(u32x4*)(pooled + (size_t)t * 1024 + c0) = w; }
          }
          __syncthreads(); }
        { const int cg8 = tid & 127, rsub = tid >> 7, c0 = cg8 * 8;
#pragma unroll
          for (int ps = 0; ps < 12; ++ps) { const int rr = ps * 4 + rsub;
              if (rr < 46) { const int t = t0 - 15 + rr; u32x4 o = (u32x4){0u, 0u, 0u, 0u};
                  if (t >= s0 && t < s1) o = *(const u32x4*)(ug + (size_t)t * 1024 + c0);
                  *(u32x4*)(shm + rr * 2048 + c0 * 2) = o; } }
          __syncthreads();
          const unsigned* ut = (const unsigned*)shm + tid;
          const f32x2 bv = *(const f32x2*)(dwb + 2 * tid);
          f32x2* red = (f32x2*)(shm + 126976);
          f32x2* stat = (f32x2*)(shm + 129024);
          float a0[16], a1[16];
#pragma unroll
          for (int t = 0; t < 16; ++t) { a0[t] = bv.x; a1[t] = bv.y; }
          f32x2 wc[4];
#pragma unroll
          for (int j = 0; j < 4; ++j) wc[j] = *(const f32x2*)(dww + j * 1024 + 2 * tid);
#pragma unroll 1
          for (int kg = 0; kg < 8; ++kg) {
              f32x2 wn[4];
#pragma unroll
              for (int j = 0; j < 4; ++j) { const int kn = kg * 4 + 4 + j; wn[j] = *(const f32x2*)(dww + (kn < 31 ? kn : 30) * 1024 + 2 * tid); }
#pragma unroll
              for (int j = 0; j < 4; ++j) { const int k = kg * 4 + j;
                  if (k < 31) { const unsigned* xr = ut + k * 512;
#pragma unroll
                      for (int t = 0; t < 16; ++t) { const unsigned uu = xr[t * 512]; fma_mix_lo(a0[t], wc[j].x, uu); fma_mix_hi(a1[t], wc[j].y, uu); } } }
#pragma unroll
              for (int j = 0; j < 4; ++j) wc[j] = wn[j];
          }
#pragma unroll
          for (int t = 0; t < 16; ++t) { float a = a0[t] + a1[t], b = a0[t] * a0[t] + a1[t] * a1[t]; a = wave_sum(a, lane); b = wave_sum(b, lane);
              if (lane == 0) red[t * 8 + wid] = (f32x2){a, b}; }
          __syncthreads();
          if (tid < 16) { float a = 0.f, b = 0.f;
#pragma unroll
              for (int w8 = 0; w8 < 8; ++w8) { const f32x2 r = red[tid * 8 + w8]; a += r.x; b += r.y; }
              const float mu = a * (1.f / 1024.f), var = fmaxf(b * (1.f / 1024.f) - mu * mu, 0.f); stat[tid] = (f32x2){mu, 1.f / sqrtf(var + EPS)}; }
          __syncthreads();
          const f32x2 cw = *(const f32x2*)(clw + 2 * tid), cb = *(const f32x2*)(clb + 2 * tid);
#pragma unroll
          for (int t = 0; t < 16; ++t) { const f32x2 st = stat[t];
              const unsigned gd = *(const unsigned*)(proj + ((unsigned)(t0 + t) * (unsigned)LDP + C_GD + 2 * tid));
              const float y0 = siluf((a0[t] - st.x) * st.y * cw.x + cb.x) * siluf(bf_lo(gd)), y1 = siluf((a1[t] - st.x) * st.y * cw.y + cb.y) * siluf(bf_hi(gd));
              *(unsigned*)(ycat + ((unsigned)(t0 + t) * 4096u + 3072 + 2 * tid)) = cvt_pk_bf16(y0, y1); }
          __syncthreads(); }
    }
}

__device__ __forceinline__ void phase_attn(const Params& p, int l, unsigned char* shm) {
    int tid_ = threadIdx.x; asm volatile("" : "+v"(tid_));
    const int tid = tid_, wid = tid >> 6, lane = tid & 63, G = gridDim.x, qr = lane & 15, kq = lane >> 4;
    const bf16_t* proj = (const bf16_t*)(p.ws + OFF_PROJ);
    const bf16_t* qb = (const bf16_t*)(p.ws + OFF_Q);
    const bf16_t* kvall = (const bf16_t*)(p.ws + OFF_KVALL);
    const bf16_t* knope = (const bf16_t*)(p.ws + OFF_KNOPE);
    const bf16_t* vt = (const bf16_t*)(p.ws + OFF_VT);
    bf16_t* ycat = (bf16_t*)(p.ws + OFF_YCAT);
    bf16_t* Qs = (bf16_t*)shm;
    bf16_t* Ks = (bf16_t*)(shm + 51200);
    bf16_t* Vs = (bf16_t*)(shm + 76800);
    const float cscale = 0.07216878364870322f * 1.4426950408889634f;
    for (int u = blockIdx.x; u < 768; u += G) {
        int h, tq, kr0, Lk, tl0; bool rope;
        if (u < 256) { const int j = u >> 6; h = (u >> 3) & 7; const int qblk = u & 7; tq = TC + j * 1024 + qblk * 128; kr0 = TC + j * 1280; Lk = 1280; rope = true; tl0 = qblk * 128; }
        else { const int v = u - 256, b = v >> 4; h = (v >> 1) & 7; const int qblk = v & 1; tq = b * 256 + qblk * 128; kr0 = b * 256; Lk = 256; rope = false; tl0 = 0; }
        __syncthreads();
#pragma unroll
        for (int ps = 0; ps < 4; ++ps) { const int id = ps * 512 + tid, r = id >> 4, c8 = id & 15;
            const u32x4 v = *(const u32x4*)(qb + (size_t)(tq + r) * 1536 + h * 192 + c8 * 8); *(u32x4*)(Qs + r * 200 + c8 * 8) = v; }
        { const int r = tid >> 2, axis = (tid >> 1) & 1, ig = tid & 1; const bf16_t* src = qb + (size_t)(tq + r) * 1536 + h * 192 + 128 + axis * 32 + ig * 8;
          u32x4 a = *(const u32x4*)src, b = *(const u32x4*)(src + 16);
          if (rope) { float x1[8], x2[8], y1[8], y2[8]; UNPACK8(a, x1); UNPACK8(b, x2); const int tl = tl0 + r; const float pos = (float)(axis ? (tl & 63) : (tl >> 6));
#pragma unroll
              for (int e = 0; e < 8; ++e) { const float ang = pos * rope_inv(ig * 8 + e); const float sn = __sinf(ang), cs = __cosf(ang); y1[e] = x1[e] * cs - x2[e] * sn; y2[e] = x2[e] * cs + x1[e] * sn; }
              PACK8(y1, a); PACK8(y2, b); }
          bf16_t* d = Qs + r * 200 + 128 + axis * 32 + ig * 8; *(u32x4*)d = a; *(u32x4*)(d + 16) = b; }
        bf16x8 qf[6];
        f32x4 o[8];
#pragma unroll
        for (int nb = 0; nb < 8; ++nb) o[nb] = (f32x4){0.f, 0.f, 0.f, 0.f};
        float m = -INFINITY, lsum = 0.f;
        u32x4 kreg[3], vreg[2];
#define ATT_LOAD(kc) do { \
            _Pragma("unroll") for (int ps = 0; ps < 3; ++ps) { const int id = ps * 512 + tid, r = id / 24, cc = id - r * 24; \
                const bf16_t* src = cc < 16 ? knope + (size_t)(kr0 + (kc) + r) * 1024 + h * 128 + cc * 8 : kvall + (size_t)(kr0 + (kc) + r) * 320 + 256 + (cc - 16) * 8; \
                kreg[ps] = *(const u32x4*)src; } \
            _Pragma("unroll") for (int ps = 0; ps < 2; ++ps) { const int id = ps * 512 + tid, d = id >> 3, c8 = id & 7; \
                vreg[ps] = *(const u32x4*)(vt + (size_t)(h * 128 + d) * KVR + kr0 + (kc) + c8 * 8); } } while (0)
#define ATT_STORE(Kb, Vb) do { \
            _Pragma("unroll") for (int ps = 0; ps < 3; ++ps) { const int id = ps * 512 + tid, r = id / 24, cc = id - r * 24; *(u32x4*)((Kb) + r * 200 + cc * 8) = kreg[ps]; } \
            _Pragma("unroll") for (int ps = 0; ps < 2; ++ps) { const int id = ps * 512 + tid, d = id >> 3, c8 = id & 7; *(u32x4*)((Vb) + d * 72 + c8 * 8) = vreg[ps]; } } while (0)
        bf16_t* const Ks1 = (bf16_t*)shm; bf16_t* const Vs1 = (bf16_t*)(shm + 25600);
        ATT_LOAD(0);
        ATT_STORE(Ks, Vs);
        __syncthreads();
#pragma unroll
        for (int c = 0; c < 6; ++c) qf[c] = *(const bf16x8*)(Qs + (wid * 16 + qr) * 200 + c * 32 + kq * 8);
        if (64 < Lk) ATT_LOAD(64);
        __syncthreads();
        for (int k0 = 0; k0 < Lk; k0 += 64) {
            const bool odd = (k0 & 64) != 0;
            const bf16_t* Kc = odd ? Ks1 : Ks; const bf16_t* Vc = odd ? Vs1 : Vs;
            if (k0 + 64 < Lk) { if (odd) ATT_STORE(Ks, Vs); else ATT_STORE(Ks1, Vs1); }
            if (k0 + 128 < Lk) ATT_LOAD(k0 + 128);
            f32x4 s[4];
#pragma unroll
            for (int kb = 0; kb < 4; ++kb) { s[kb] = (f32x4){0.f, 0.f, 0.f, 0.f};
#pragma unroll
                for (int c = 0; c < 6; ++c) { const bf16x8 kf = *(const bf16x8*)(Kc + (kb * 16 + qr) * 200 + c * 32 + kq * 8); s[kb] = __builtin_amdgcn_mfma_f32_16x16x32_bf16(kf, qf[c], s[kb], 0, 0, 0); } }
            float mx = s[0][0];
#pragma unroll
            for (int kb = 0; kb < 4; ++kb)
#pragma unroll
                for (int j = 0; j < 4; ++j) mx = fmaxf(mx, s[kb][j]);
            mx = fmaxf(mx, swz_xor<16>(mx)); mx = fmaxf(mx, bperm_xor32(mx, lane));
            const float mn = fmaxf(m, mx), alpha = __builtin_amdgcn_exp2f((m - mn) * cscale); m = mn;
            float psum = 0.f;
#pragma unroll
            for (int kb = 0; kb < 4; ++kb)
#pragma unroll
                for (int j = 0; j < 4; ++j) { const float e = __builtin_amdgcn_exp2f((s[kb][j] - mn) * cscale); s[kb][j] = e; psum += e; }
            lsum = lsum * alpha + psum;
#pragma unroll
            for (int nb = 0; nb < 8; ++nb) o[nb] *= alpha;
#pragma unroll
            for (int hb = 0; hb < 2; ++hb) {
                u32x4 pw; pw.x = cvt_pk_bf16(s[2 * hb][0], s[2 * hb][1]); pw.y = cvt_pk_bf16(s[2 * hb][2], s[2 * hb][3]); pw.z = cvt_pk_bf16(s[2 * hb + 1][0], s[2 * hb + 1][1]); pw.w = cvt_pk_bf16(s[2 * hb + 1][2], s[2 * hb + 1][3]);
                const bf16x8 pf = __builtin_bit_cast(bf16x8, pw);
#pragma unroll
                for (int nb = 0; nb < 8; ++nb) { const bf16_t* vp = Vc + (nb * 16 + qr) * 72 + hb * 32 + kq * 4;
                    const u32x2 lo = *(const u32x2*)vp, hi = *(const u32x2*)(vp + 16);
                    const u32x4 vw = (u32x4){lo.x, lo.y, hi.x, hi.y};
                    o[nb] = __builtin_amdgcn_mfma_f32_16x16x32_bf16(__builtin_bit_cast(bf16x8, vw), pf, o[nb], 0, 0, 0); } }
            __syncthreads();
        }
        float lt = lsum + swz_xor<16>(lsum); lt += bperm_xor32(lt, lane);
        const float inv = 1.f / lt;
        const int token = tq + wid * 16 + qr;
#pragma unroll
        for (int nb = 0; nb < 8; ++nb) { const int dv0 = nb * 16 + kq * 4;
            const u32x2 ga = *(const u32x2*)(proj + (size_t)token * LDP + C_GA + h * 128 + dv0);
            const float y0 = o[nb][0] * inv * siluf(bf_lo(ga.x)), y1 = o[nb][1] * inv * siluf(bf_hi(ga.x)), y2 = o[nb][2] * inv * siluf(bf_lo(ga.y)), y3 = o[nb][3] * inv * siluf(bf_hi(ga.y));
            u32x2 w; w.x = cvt_pk_bf16(y0, y1); w.y = cvt_pk_bf16(y2, y3);
            *(u32x2*)(ycat + (size_t)token * 4096 + h * 128 + dv0) = w; }
    }
}

#define XB_TMO      128
#define XB_XCNT(j)  (256  + 64 * (j))
#define XB_XSUB(j)  (1280 + 64 * (j))
#define XB_XGEN(j)  (2304 + 64 * (j))
#define XB_TOP      3328
#define XB_TOPGEN   3392
#define XB_SPIN_CAP (1u << 22)
__device__ __forceinline__ unsigned xb_ld(unsigned* p)              { return __hip_atomic_load(p, __ATOMIC_RELAXED, __HIP_MEMORY_SCOPE_AGENT); }
__device__ __forceinline__ unsigned xb_add(unsigned* p, unsigned v) { return __hip_atomic_fetch_add(p, v, __ATOMIC_RELAXED, __HIP_MEMORY_SCOPE_AGENT); }
__device__ __forceinline__ unsigned xb_xcc_id() { return (unsigned)__builtin_amdgcn_s_getreg((3 << 11) | 20) & 0xFu; }
#define XB_SPIN(cond, bar) do { unsigned _sp = 0; while (cond) { __builtin_amdgcn_s_sleep(1); \
    if ((++_sp & 255u) == 0u) { if (xb_ld(&(bar)[XB_TMO])) break; if (_sp > XB_SPIN_CAP) { atomicAdd(&(bar)[XB_TMO], 1u); break; } } } } while (0)
__device__ __forceinline__ void xcd_barrier_complete(unsigned* bar, unsigned x, unsigned& nloc, unsigned& nx) {
    const unsigned G = gridDim.x * gridDim.y * gridDim.z;
    unsigned sum, cnt, mine, sp = 0u;
    for (;;) {
        sum = 0u; cnt = 0u; mine = 0u;
#pragma unroll
        for (unsigned j = 0; j < 16; ++j) { const unsigned c = xb_ld(&bar[XB_XCNT(j)]); sum += c; cnt += (c > 0u) ? 1u : 0u; mine = (j == x) ? c : mine; }
        if (sum == G) break;
        __builtin_amdgcn_s_sleep(1);
        if ((++sp & 255u) == 0u) { if (xb_ld(&bar[XB_TMO])) break; if (sp > XB_SPIN_CAP) { atomicAdd(&bar[XB_TMO], 1u); break; } }
    }
    nloc = mine > 0u ? mine : 1u; nx = cnt > 0u ? cnt : 1u;
}
__device__ __forceinline__ void xcd_barrier(unsigned* bar, volatile LAS unsigned* st) {
    asm volatile("s_waitcnt vmcnt(0)" ::: "memory");
    __syncthreads();
    if (threadIdx.x == 0) {
        const unsigned x = xb_xcc_id();
        __builtin_amdgcn_s_waitcnt(0);
        unsigned nloc = st[0], nx = st[1];
        if (nloc == 0u) { xcd_barrier_complete(bar, x, nloc, nx); st[0] = nloc; st[1] = nx; }
        const unsigned old = xb_add(&bar[XB_XSUB(x)], 1u);
        const unsigned gen = old / nloc;
        if (old + 1u == (gen + 1u) * nloc) {
            __builtin_amdgcn_fence(__ATOMIC_RELEASE, "agent");
            asm volatile("s_waitcnt vmcnt(0)" ::: "memory");
            const unsigned og = xb_add(&bar[XB_TOP], 1u);
            const unsigned tg = og / nx;
            if (og + 1u == (tg + 1u) * nx) xb_add(&bar[XB_TOPGEN], 1u);
            else XB_SPIN(xb_ld(&bar[XB_TOPGEN]) == tg, bar);
            __builtin_amdgcn_fence(__ATOMIC_ACQUIRE, "agent");
            xb_add(&bar[XB_XGEN(x)], 1u);
            asm volatile("s_waitcnt vmcnt(0)" ::: "memory");
        } else {
            XB_SPIN(xb_ld(&bar[XB_XGEN(x)]) == gen, bar);
            __builtin_amdgcn_fence(__ATOMIC_ACQUIRE, "agent");
            asm volatile("s_waitcnt vmcnt(0)" ::: "memory");
        }
    }
    __syncthreads();
}

#define LAUNDER() \
        int z_ = 0; asm volatile("" : "+s"(z_)); \
        const __attribute__((address_space(4))) unsigned char* kp_ = (const __attribute__((address_space(4))) unsigned char*)__builtin_amdgcn_kernarg_segment_ptr(); \
        asm volatile("" : "+s"(kp_)); \
        const Params& p = *(const Params*)kp_; \
        LAS unsigned char* lds = lds0 + z_; \
        unsigned char* shm = (unsigned char*)lds; (void)shm; (void)lds; (void)p;
#define RUNPH(idx, ...) do { const int idx_ = (idx); if (idx_ >= ph_lo && idx_ < ph_hi) { { LAUNDER() __VA_ARGS__ } if (idx_ + 1 < ph_hi) { LAUNDER() xcd_barrier((unsigned*)(p.ws + OFF_BAR), (volatile LAS unsigned*)(lds0 + 131072)); } } } while (0)

template <int l> __device__ __forceinline__ void run_layer(cg::grid_group& grid, LAS unsigned char* lds0, int ph_lo, int ph_hi) {
        constexpr int pb = 1 + 8 * l;

        RUNPH(pb + 0, { if (l == 0) phase_norm(p, 0, 0, T, (int)gridDim.x, (int)blockIdx.x); else phase_norm(p, l, TC, T, (int)gridDim.x, (int)blockIdx.x); });
        RUNPH(pb + 1, {
            const int G = gridDim.x, bid = blockIdx.x;
            pg8::Gemm g; pg8::EpiWin e;
            g.A = (const bf16_t*)(p.ws + OFF_H); g.lda = 2048; g.Bt = (const bf16_t*)(p.ws + OFF_WIN + l * SZ_WIN1); g.ldb = 2048; g.M = T; g.N = NIN; g.K = 2048; e.O = (bf16_t*)(p.ws + OFF_PROJ); e.R = (unsigned short*)(p.ws + OFF_RAT); e.U = (bf16_t*)(p.ws + OFF_U); e.xp = (LAS unsigned*)(lds + LDS_XP);
            pg8::StaticOrder S; S.init(g.M, g.N, G, bid);
            pg8::gemm_phase<pg8::EpiWin>(lds, g, S, e);
            if (l == 0) { const int extra = S.nwg % G;
                if (extra > 0) { if (bid >= extra) conv_jobs(p, shm, 1, 26, G - extra, bid - extra); }
                else conv_jobs(p, shm, 1, 26, G, bid); } });
        RUNPH(pb + 2, phase_elem(p, l, shm););
        RUNPH(pb + 3, {
            const int G = gridDim.x, bid = blockIdx.x;
            int start = 0;
            { pg8::Gemm g; pg8::EpiBf16 e;
              g.A = (const bf16_t*)(p.ws + OFF_QN); g.lda = 512; g.Bt = (const bf16_t*)(p.ws + OFF_WQB + l * SZ_WQB1); g.ldb = 512; g.M = T; g.N = 1536; g.K = 512; e.O = (bf16_t*)(p.ws + OFF_Q); e.ldc = 1536;
              pg8::StaticOrder S; S.init(g.M, g.N, G, bid);
              pg8::gemm_phase<pg8::EpiBf16>(lds, g, S, e); start += S.nwg; }
            { LAUNDER()
              pg8::Gemm g; pg8::EpiBf16 e;
              g.A = (const bf16_t*)(p.ws + OFF_KVALL); g.lda = 320; g.Bt = (const bf16_t*)(p.ws + OFF_WK + l * SZ_WK1); g.ldb = 256; g.M = KVR; g.N = 1024; g.K = 256; e.O = (bf16_t*)(p.ws + OFF_KNOPE); e.ldc = 1024;
              pg8::StaticOrder S; S.init(g.M, g.N, G, (bid - start % G + G) % G);
              pg8::gemm_phase<pg8::EpiBf16>(lds, g, S, e); start += S.nwg; }
            { LAUNDER()
              pg8::Gemm g; pg8::EpiBf16 e;
              g.A = (const bf16_t*)(p.ws + OFF_WV + l * SZ_WK1); g.lda = 256; g.Bt = (const bf16_t*)(p.ws + OFF_KVALL); g.ldb = 320; g.M = 1024; g.N = KVR; g.K = 256; e.O = (bf16_t*)(p.ws + OFF_VT); e.ldc = KVR;
              pg8::StaticOrder S; S.init(g.M, g.N, G, (bid - start % G + G) % G);
              pg8::gemm_phase<pg8::EpiBf16>(lds, g, S, e); start += S.nwg; }
            { LAUNDER()
              const int G2 = gridDim.x;
              pg8::Gemm g; g.A = (const bf16_t*)(p.ws + OFF_POOLED); g.lda = 1024; g.a_pn = 256; g.Bt = (const bf16_t*)(p.ws + OFF_WPOOL + l * SZ_WPOOL1); g.ldb = 256; g.M = T; g.N = 1024; g.K = 256;
              pg8::EpiPool e; e.O = (bf16_t*)(p.ws + OFF_YCAT) + 2048; e.scale = p.in[16] + l * 1024; e.gc = (const bf16_t*)(p.ws + OFF_PROJ) + C_GC;
              pg8::StaticOrder S; S.init(g.M, g.N, G2, ((int)blockIdx.x + G2 - start % G2) % G2);
              pg8::gemm_phase<pg8::EpiPool>(lds, g, S, e); } });
        RUNPH(pb + 4, phase_attn(p, l, shm););
#define MK_MERGE_GEMM(Mrows, Gx, cx, pmo) do { \
            pg8::Gemm g; g.A = (const bf16_t*)(p.ws + OFF_YCAT); g.lda = 4096; g.Bt = (const bf16_t*)(p.ws + OFF_WBP + l * SZ_WBP1); g.ldb = 4096; g.M = (Mrows); g.N = 2048; g.K = 4096; \
            pg8::EpiMerge e; e.R = (const unsigned short*)(p.ws + OFF_RAT); e.O = (bf16_t*)(p.ws + OFF_MERGED); \
            pg8::StaticOrder S; S.init(g.M, g.N, (Gx), (cx), (pmo)); \
            pg8::gemm_phase<pg8::EpiMerge>(lds, g, S, e); } while (0)
#define MK_OUT_GEMM(Mrows, Gx, cx, pmo) do { \
            pg8::Gemm g; g.A = (const bf16_t*)(p.ws + OFF_MERGED); g.lda = 2048; g.Bt = (const bf16_t*)(p.ws + OFF_WOUT + l * SZ_WOUT1); g.ldb = 2048; g.M = (Mrows); g.N = 2048; g.K = 2048; \
            pg8::EpiRes e; float* xres = (float*)(p.ws + OFF_XRES); \
            e.xin0 = l == 0 ? p.in[0] : xres; e.xin1 = l == 0 ? p.in[1] - (size_t)TC * 2048 : xres; e.xo = xres; e.modl = (const float*)(p.ws + OFF_MOD) + (size_t)l * 5 * 6144; \
            pg8::StaticOrder S; S.init(g.M, g.N, (Gx), (cx), (pmo)); \
            pg8::gemm_phase<pg8::EpiRes>(lds, g, S, e); } while (0)
        RUNPH(pb + 5, { MK_MERGE_GEMM(8192, (int)gridDim.x, (int)blockIdx.x, 0); });
        RUNPH(pb + 6, { const int G = gridDim.x, bid = blockIdx.x, hg = G / 2;
            if (bid < hg) MK_MERGE_GEMM(4096, hg, bid, 32);
            else MK_OUT_GEMM(8192, G - hg, bid - hg, 0); });
        RUNPH(pb + 7, { const int G = gridDim.x, bid = blockIdx.x, hg = G / 2;
            if (bid < hg) MK_OUT_GEMM(4096, hg, bid, 32);
            else if (l == 0) phase_norm(p, 1, 0, TC, G - hg, bid - hg);
            else phase_final(p, 0, TC, G - hg, bid - hg); });
}

__global__ __launch_bounds__(512, 2) void mega(Params p_arg) {
    extern __shared__ __attribute__((aligned(16))) unsigned char shm0[];
    LAS unsigned char* lds0 = (LAS unsigned char*)shm0;
    cg::grid_group grid = cg::this_grid();
    const int ph_lo = p_arg.ph_lo, ph_hi = p_arg.ph_hi;
    if (ph_hi < 0) grid.sync();
    { volatile LAS unsigned* st = (volatile LAS unsigned*)(lds0 + 131072);
      if (threadIdx.x == 0) { st[0] = 0u; st[1] = 0u; st[2] = 0u; st[3] = 0u; }
      __syncthreads();
      if (threadIdx.x == 0) (void)xb_add(&((unsigned*)(p_arg.ws + OFF_BAR))[XB_XCNT(xb_xcc_id())], 1u); }
    RUNPH(0, phase_prep(p, shm););
    run_layer<0>(grid, lds0, ph_lo, ph_hi);
    run_layer<1>(grid, lds0, ph_lo, ph_hi);
    RUNPH(NPHASE - 1, phase_final(p, TC, T, (int)gridDim.x, (int)blockIdx.x););
}

#ifndef MK_PER_PHASE
#define MK_PER_PHASE 0
#endif

extern "C" void kernel_launch(void* const* d_in, const int* in_sizes, int n_in, void* d_out, int out_size, void* d_ws, size_t ws_size, hipStream_t stream) {
    static int grid = 0;
    if (grid == 0) {
        int dev = 0, cus = 0, per_cu = 0;
        hipGetDevice(&dev);
        hipDeviceGetAttribute(&cus, hipDeviceAttributeMultiprocessorCount, dev);
        if (hipFuncSetAttribute((const void*)mega, hipFuncAttributeMaxDynamicSharedMemorySize, LDS_BYTES) != hipSuccess) { fprintf(stderr, "hipFuncSetAttribute failed\n"); }
        if (hipOccupancyMaxActiveBlocksPerMultiprocessor(&per_cu, (const void*)mega, 512, LDS_BYTES) != hipSuccess || per_cu < 1) { fprintf(stderr, "occupancy query: %d\n", per_cu); per_cu = 1; }
        (void)hipGetLastError();
        grid = cus * 1;
        if (ws_size < WS_END) { fprintf(stderr, "workspace too small: %zu < %zu\n", ws_size, (size_t)WS_END); grid = -1; }
    }
    if (grid < 0) return;
    if (hipMemsetAsync((char*)d_ws + OFF_BAR, 0, BAR_BYTES, stream) != hipSuccess) { fprintf(stderr, "memset of barrier words failed\n"); return; }
    Params p{};
    for (int i = 0; i < 24; ++i) p.in[i] = (const float*)d_in[i];
    p.out = (float*)d_out; p.ws = (unsigned char*)d_ws;
#if MK_PER_PHASE
    for (int ph = 0; ph < NPHASE; ++ph) { p.ph_lo = ph; p.ph_hi = ph + 1; hipLaunchKernelGGL(mega, dim3(grid), dim3(512), LDS_BYTES, stream, p); }
#else
    p.ph_lo = 0; p.ph_hi = NPHASE;
    void* args[] = {&p};
    hipError_t e = hipLaunchCooperativeKernel((const void*)mega, dim3(grid), dim3(512), args, LDS_BYTES, stream);
    if (e != hipSuccess) fprintf(stderr, "cooperative launch failed: %s (grid %d)\n", hipGetErrorString(e), grid);
#endif
}
```

```cpp
#include <hip/hip_runtime.h>
#include <hip/hip_cooperative_groups.h>
#include <cstdio>
namespace cg = cooperative_groups;

#define LAS __attribute__((address_space(3)))
typedef unsigned short bf16_t;
typedef short bf16x8 __attribute__((ext_vector_type(8)));
typedef float f32x4 __attribute__((ext_vector_type(4)));
typedef float f32x2 __attribute__((ext_vector_type(2)));
typedef unsigned u32x4 __attribute__((ext_vector_type(4)));
typedef unsigned u32x2 __attribute__((ext_vector_type(2)));

constexpr int T = 12288, TC = 8192, DM = 2048, BW = 1024, LDP = 11264, NIN = 19456, KVR = 13312, INC = 19264;
constexpr int C_KVA = 512, C_GA = 896, C_BG = 1920, C_CG = 2944, C_XC = 3968, C_GB = 4992, C_XP = 6016, C_GC = 7040, C_GLU = 8192, C_GD = 10240, C_ML = 11264;
constexpr float EPS = 1e-6f;
constexpr int LDS_XP = 131072 + 16;
constexpr int LDS_BYTES = 131072 + 16 + 8192;
constexpr int NPHASE = 18;

constexpr size_t SZ_WIN1 = (size_t)NIN * 2048 * 2;
constexpr size_t SZ_WBP1 = (size_t)2048 * 4096 * 2;
constexpr size_t SZ_WOUT1 = (size_t)2048 * 2048 * 2;
constexpr size_t SZ_WQB1 = (size_t)1536 * 512 * 2;
constexpr size_t SZ_WK1 = (size_t)1024 * 256 * 2;
constexpr size_t SZ_WPOOL1 = (size_t)4 * 256 * 256 * 2;
constexpr size_t OFF_WIN = 0;
constexpr size_t OFF_WBP = OFF_WIN + 2 * SZ_WIN1;
constexpr size_t OFF_WOUT = OFF_WBP + 2 * SZ_WBP1;
constexpr size_t OFF_WQB = OFF_WOUT + 2 * SZ_WOUT1;
constexpr size_t OFF_WK = OFF_WQB + 2 * SZ_WQB1;
constexpr size_t OFF_WV = OFF_WK + 2 * SZ_WK1;
constexpr size_t OFF_WPOOL = OFF_WV + 2 * SZ_WK1;
constexpr size_t OFF_MOD = OFF_WPOOL + 2 * SZ_WPOOL1;
constexpr size_t OFF_H = OFF_MOD + (size_t)2 * 5 * 6144 * 4;
constexpr size_t OFF_PROJ = OFF_H + (size_t)T * 2048 * 2;
constexpr size_t OFF_QN = OFF_PROJ + (size_t)T * LDP * 2;
constexpr size_t OFF_KVALL = OFF_QN + (size_t)T * 512 * 2;
constexpr size_t OFF_POOLED = OFF_KVALL + (size_t)KVR * 320 * 2;
constexpr size_t OFF_YCAT = OFF_POOLED + (size_t)T * 1024 * 2;
constexpr size_t OFF_Q = OFF_YCAT + (size_t)T * 4096 * 2;
constexpr size_t OFF_KNOPE = OFF_Q + (size_t)T * 1536 * 2;
constexpr size_t OFF_VT = OFF_KNOPE + (size_t)KVR * 1024 * 2;
constexpr size_t OFF_MERGED = OFF_VT + (size_t)KVR * 1024 * 2;
constexpr size_t OFF_XRES = OFF_MERGED + (size_t)T * 2048 * 2;
constexpr size_t OFF_RAT = OFF_XRES + (size_t)T * 2048 * 4;
constexpr size_t OFF_U = OFF_RAT + (size_t)T * 8192 * 2;
constexpr size_t OFF_BAR = OFF_U + (size_t)T * 1024 * 2;
constexpr size_t BAR_BYTES = 16384;
constexpr size_t WS_END = OFF_BAR + BAR_BYTES;

struct Params {
    const float* in[24];
    float* out;
    unsigned char* ws;
    int ph_lo, ph_hi;
};

typedef float f32x2v __attribute__((ext_vector_type(2)));
typedef __bf16 bf16x2v __attribute__((ext_vector_type(2)));
__device__ __forceinline__ unsigned cvt_pk_bf16(float lo, float hi) { const f32x2v v = {lo, hi}; const bf16x2v r = __builtin_convertvector(v, bf16x2v); return __builtin_bit_cast(unsigned, r); }
__device__ __forceinline__ float bf_lo(unsigned u) { return __uint_as_float(u << 16); }
__device__ __forceinline__ float bf_hi(unsigned u) { return __uint_as_float(u & 0xffff0000u); }
__device__ __forceinline__ float siluf(float x) { return x * __builtin_amdgcn_rcpf(1.f + __expf(-x)); }
__device__ __forceinline__ float sigmf(float x) { return __builtin_amdgcn_rcpf(1.f + __expf(-x)); }
template <int O> __device__ __forceinline__ float swz_xor(float v) { return __int_as_float(__builtin_amdgcn_ds_swizzle(__float_as_int(v), (O << 10) | 0x1f)); }
__device__ __forceinline__ float bperm_xor32(float v, int lane) { return __int_as_float(__builtin_amdgcn_ds_bpermute((lane ^ 32) << 2, __float_as_int(v))); }
__device__ __forceinline__ float wave_sum(float v, int lane) {
    v += bperm_xor32(v, lane); v += swz_xor<16>(v); v += swz_xor<8>(v); v += swz_xor<4>(v); v += swz_xor<2>(v); v += swz_xor<1>(v);
    return v;
}
#define UNPACK8(v, f) do { f[0] = bf_lo(v.x); f[1] = bf_hi(v.x); f[2] = bf_lo(v.y); f[3] = bf_hi(v.y); f[4] = bf_lo(v.z); f[5] = bf_hi(v.z); f[6] = bf_lo(v.w); f[7] = bf_hi(v.w); } while (0)
#define PACK8(f, v) do { v.x = cvt_pk_bf16(f[0], f[1]); v.y = cvt_pk_bf16(f[2], f[3]); v.z = cvt_pk_bf16(f[4], f[5]); v.w = cvt_pk_bf16(f[6], f[7]); } while (0)
__device__ __forceinline__ void fma_mix_lo(float& acc, float w, unsigned x) { asm("v_fma_mix_f32 %0, %1, %2, %0 op_sel:[0,0,0] op_sel_hi:[0,1,0]" : "+v"(acc) : "v"(w), "v"(x)); }
__device__ __forceinline__ void fma_mix_hi(float& acc, float w, unsigned x) { asm("v_fma_mix_f32 %0, %1, %2, %0 op_sel:[0,1,0] op_sel_hi:[0,1,0]" : "+v"(acc) : "v"(w), "v"(x)); }
__device__ __forceinline__ float rope_inv(int i) { return __expf(-(float)i * 0.5756462732485114f); }

namespace pg8 {
constexpr int BM = 256, BK = 64, HALF = 128, HTB = HALF * BK * 2, NXCD = 8, WGM = 8;
__device__ __forceinline__ int lds_byte(int r, int c) { const int st = (r >> 4) * 2 + (c >> 5), rr = r & 15, cc = c & 31, ob = rr * 64 + cc * 2; return st * 1024 + (ob ^ (((ob >> 9) & 1) << 5)); }
__device__ __forceinline__ void stage_rc(int b, int& R, int& C) { const int st = b / 1024, sb = b % 1024, swz = sb ^ (((sb >> 9) & 1) << 5); R = (st >> 1) * 16 + swz / 64; C = (st & 1) * 32 + (swz % 64) / 2; }
__device__ __forceinline__ int perm32(int rho) { const int n = rho >> 4, i = rho & 15; return 8 * (i >> 2) + 4 * n + (i & 3); }
struct Unit { int pm, pn; };
struct Gemm { const bf16_t* A; const bf16_t* Bt; int M, N, K, lda, ldb; int a_pn = 0; };
struct StaticOrder {
    int nM, nN, nwg, G, c, pm_off;
    __device__ void init(int M, int N, int G_, int c_, int pm_off_ = 0) { nM = M / BM; nN = N / BM; nwg = nM * nN; G = G_; c = c_; pm_off = pm_off_; }
    __device__ bool next(int i, Unit& u) const {
        const long L = (long)i * G + c; if (L >= nwg) return false;
        int wgid = (int)L; { const int q = nwg / NXCD, r = nwg % NXCD, xcd = wgid % NXCD, off = wgid / NXCD; wgid = (xcd < r ? xcd * (q + 1) : r * (q + 1) + (xcd - r) * q) + off; }
        const int nig = WGM * nN, gid = wgid / nig, fm = gid * WGM, gsz = (nM - fm) < WGM ? (nM - fm) : WGM;
        u.pm = pm_off + fm + ((wgid % nig) % gsz); u.pn = (wgid % nig) / gsz; return true;
    }
};
template <class Epi>
__device__ __forceinline__ void gemm_phase(LAS unsigned char* lds, const Gemm g, const StaticOrder& S, const Epi& E) {
    int tid_ = threadIdx.x; asm volatile("" : "+v"(tid_));
    const int tid = tid_, wid = __builtin_amdgcn_readfirstlane(tid >> 6), lane = tid & 63, wr = wid >> 2, wc = wid & 3, fr = lane & 15, fq = lane >> 4;
    const int K = g.K, nt = K / BK;
    unsigned voffA[2], voffB[2];
#pragma unroll
    for (int i = 0; i < 2; ++i) { int R, C; stage_rc(tid * 16 + i * 8192, R, C); const int Rb = Epi::PERM ? ((R & ~31) + perm32(R & 31)) : R;
        voffA[i] = (unsigned)(R * g.lda + C) * 2u; voffB[i] = (unsigned)(Rb * g.ldb + C) * 2u; }
    const size_t kstep = (size_t)(BK * 2);
    const size_t hstepA = (size_t)HALF * g.lda * 2, hstepB = (size_t)HALF * g.ldb * 2;
    const size_t tstepA = 2 * hstepA, tstepB = 2 * hstepB;
    const unsigned ldsw = (unsigned)wid * 1024u;
    const int aoff = lds_byte(wr * 64 + fr, fq * 8), boff = lds_byte(wc * 32 + fr, fq * 8);
#define PG8_SA(b, h) (((b) * 2 + (h)) * HTB)
#define PG8_SB(b, h) ((4 + (b) * 2 + (h)) * HTB)
#define PG8_STAGE(bufoff, gbase, voff) do { const char* _gb = (const char*)(gbase); asm volatile("" : "+s"(_gb)); _Pragma("unroll") for (int _i = 0; _i < 2; ++_i) \
        __builtin_amdgcn_global_load_lds((const unsigned*)(_gb + (voff)[_i]), (LAS unsigned*)(lds + (bufoff) + ldsw + _i * 8192), 16, 0, 0); } while (0)
#define PG8_LDA(dst, b, h) do { _Pragma("unroll") for (int m = 0; m < 4; ++m) _Pragma("unroll") for (int k = 0; k < 2; ++k) dst[m][k] = *(const LAS bf16x8*)(lds + PG8_SA(b, h) + aoff + m * 2048 + k * 1024); } while (0)
#define PG8_LDB(dst, b, h) do { _Pragma("unroll") for (int n = 0; n < 2; ++n) _Pragma("unroll") for (int k = 0; k < 2; ++k) dst[n][k] = *(const LAS bf16x8*)(lds + PG8_SB(b, h) + boff + n * 2048 + k * 1024); } while (0)
#define PG8_MMA(ai, bj, At, Bt) do { __builtin_amdgcn_s_setprio(1); _Pragma("unroll") for (int m = 0; m < 4; ++m) _Pragma("unroll") for (int n = 0; n < 2; ++n) _Pragma("unroll") for (int k = 0; k < 2; ++k) \
        acc[ai][bj][m][n] = __builtin_amdgcn_mfma_f32_16x16x32_bf16(Bt[n][k], At[m][k], acc[ai][bj][m][n], 0, 0, 0); __builtin_amdgcn_s_setprio(0); } while (0)
#define PG8_WAIT_V(n) asm volatile("s_waitcnt vmcnt(" #n ")" ::: "memory")
#define PG8_WAIT_L(n) asm volatile("s_waitcnt lgkmcnt(" #n ")" ::: "memory")
#define PG8_BAR __builtin_amdgcn_s_barrier()
#define PG8_SCHED __builtin_amdgcn_sched_barrier(0)
    Unit cur, nxt; int ui = 0;
    if (!S.next(0, cur)) return;
    const char* cA = (const char*)g.A + (size_t)cur.pm * tstepA + (size_t)(cur.pn * g.a_pn) * 2; const char* cB = (const char*)g.Bt + (size_t)cur.pn * tstepB;
    PG8_STAGE(PG8_SB(0, 0), cB, voffB); PG8_STAGE(PG8_SA(0, 0), cA, voffA); PG8_STAGE(PG8_SB(0, 1), cB + hstepB, voffB); PG8_STAGE(PG8_SA(0, 1), cA + hstepA, voffA);
    if (wr == 1) PG8_BAR;
    PG8_WAIT_V(4); PG8_BAR;
    PG8_STAGE(PG8_SB(1, 0), cB + kstep, voffB); PG8_STAGE(PG8_SA(1, 0), cA + kstep, voffA); PG8_STAGE(PG8_SB(1, 1), cB + hstepB + kstep, voffB);
    PG8_WAIT_V(6); PG8_BAR;
    f32x4 acc[2][2][4][2];
#pragma unroll
    for (int a = 0; a < 2; ++a)
#pragma unroll
        for (int b = 0; b < 2; ++b)
#pragma unroll
            for (int m = 0; m < 4; ++m)
#pragma unroll
                for (int n = 0; n < 2; ++n) acc[a][b][m][n] = (f32x4){0.f, 0.f, 0.f, 0.f};
    bf16x8 At[4][2], B0[2][2], B1[2][2];
    for (;;) {
        const bool has_next = S.next(ui + 1, nxt);
        const char* nA = has_next ? (const char*)g.A + (size_t)nxt.pm * tstepA + (size_t)(nxt.pn * g.a_pn) * 2 : cA; const char* nB = has_next ? (const char*)g.Bt + (size_t)nxt.pn * tstepB : cB;
        for (int t = 0; t < nt; t += 2) {
            const bool last = (t == nt - 2);
            const char* a1 = cA + (size_t)(t + 1) * kstep;
            const char* a2 = last ? nA : cA + (size_t)(t + 2) * kstep; const char* b2 = last ? nB : cB + (size_t)(t + 2) * kstep;
            const char* a3 = a2 + kstep; const char* b3 = b2 + kstep;
            if constexpr (Epi::MID) { if (t != 0 && (t & 15) == 0) E.mid(acc, cur, t >> 4, wr, wc, fr, fq); }
            PG8_LDB(B0, 0, 0); PG8_SCHED; PG8_LDA(At, 0, 0); PG8_STAGE(PG8_SA(1, 1), a1 + hstepA, voffA);
            PG8_WAIT_L(8); PG8_BAR; PG8_WAIT_L(0); PG8_MMA(0, 0, At, B0); PG8_BAR; PG8_SCHED;
            PG8_LDB(B1, 0, 1); PG8_STAGE(PG8_SB(0, 0), b2, voffB);
            PG8_BAR; PG8_WAIT_L(0); PG8_MMA(0, 1, At, B1); PG8_BAR;
            PG8_LDA(At, 0, 1); PG8_STAGE(PG8_SA(0, 0), a2, voffA);
            PG8_BAR; PG8_WAIT_L(0); PG8_MMA(1, 0, At, B0); PG8_BAR; PG8_SCHED;
            PG8_STAGE(PG8_SB(0, 1), b2 + hstepB, voffB);
            PG8_WAIT_V(6); PG8_BAR; PG8_MMA(1, 1, At, B1); PG8_BAR;
            PG8_LDB(B0, 1, 0); PG8_SCHED; PG8_LDA(At, 1, 0); PG8_STAGE(PG8_SA(0, 1), a2 + hstepA, voffA);
            PG8_WAIT_L(8); PG8_BAR; PG8_WAIT_L(0); PG8_MMA(0, 0, At, B0); PG8_BAR; PG8_SCHED;
            PG8_LDB(B1, 1, 1); PG8_STAGE(PG8_SB(1, 0), b3, voffB);
            PG8_BAR; PG8_WAIT_L(0); PG8_MMA(0, 1, At, B1); PG8_BAR;
            PG8_LDA(At, 1, 1); PG8_STAGE(PG8_SA(1, 0), a3, voffA);
            PG8_BAR; PG8_WAIT_L(0); PG8_MMA(1, 0, At, B0); PG8_BAR; PG8_SCHED;
            PG8_STAGE(PG8_SB(1, 1), b3 + hstepB, voffB);
            PG8_WAIT_V(6); PG8_BAR; PG8_MMA(1, 1, At, B1); PG8_BAR;
        }
        E(acc, cur, wr, wc, fr, fq);
        if (!has_next) break;
#pragma unroll
        for (int a = 0; a < 2; ++a)
#pragma unroll
            for (int b = 0; b < 2; ++b)
#pragma unroll
                for (int m = 0; m < 4; ++m)
#pragma unroll
                    for (int n = 0; n < 2; ++n) acc[a][b][m][n] = (f32x4){0.f, 0.f, 0.f, 0.f};
        cur = nxt; cA = nA; cB = nB; ++ui;
    }
    PG8_WAIT_V(0);
    if (wr == 0) PG8_BAR;
    PG8_BAR;
#undef PG8_SA
#undef PG8_SB
#undef PG8_STAGE
#undef PG8_LDA
#undef PG8_LDB
#undef PG8_MMA
#undef PG8_WAIT_V
#undef PG8_WAIT_L
#undef PG8_BAR
#undef PG8_SCHED
}

struct EpiBf16 {
    static constexpr bool PERM = true, MID = false;
    bf16_t* O; int ldc;
    __device__ __forceinline__ void operator()(f32x4 (&acc)[2][2][4][2], const Unit& u, int wr, int wc, int fr, int fq) const {
        const int row0 = u.pm * BM + wr * 64 + fr, col0 = u.pn * BM + wc * 32 + 8 * fq;
#pragma unroll
        for (int ai = 0; ai < 2; ++ai)
#pragma unroll
            for (int m = 0; m < 4; ++m) { const unsigned ro = (unsigned)(row0 + ai * HALF + m * 16) * (unsigned)ldc + (unsigned)col0;
#pragma unroll
                for (int bj = 0; bj < 2; ++bj) { const f32x4 v0 = acc[ai][bj][m][0], v1 = acc[ai][bj][m][1];
                    u32x4 w; w.x = cvt_pk_bf16(v0[0], v0[1]); w.y = cvt_pk_bf16(v0[2], v0[3]); w.z = cvt_pk_bf16(v1[0], v1[1]); w.w = cvt_pk_bf16(v1[2], v1[3]);
                    *(u32x4*)(O + (ro + bj * HALF)) = w; } }
    }
};
__device__ __forceinline__ float h2f_lo(unsigned u) { return (float)__builtin_bit_cast(_Float16, (unsigned short)(u & 0xffffu)); }
__device__ __forceinline__ float h2f_hi(unsigned u) { return (float)__builtin_bit_cast(_Float16, (unsigned short)(u >> 16)); }
__device__ __forceinline__ unsigned f2h_pk(float a, float b) { return (unsigned)__builtin_bit_cast(unsigned short, (_Float16)a) | ((unsigned)__builtin_bit_cast(unsigned short, (_Float16)b) << 16); }
struct EpiWin {
    static constexpr bool PERM = true, MID = false;
    bf16_t* O; unsigned short* R; bf16_t* U; LAS unsigned* xp;
    __device__ __forceinline__ void operator()(f32x4 (&acc)[2][2][4][2], const Unit& u, int wr, int wc, int fr, int fq) const {
        if (u.pn >= C_GLU / BM && u.pn < C_GD / BM) {
            const int row0g = u.pm * BM + wr * 64 + fr, ch0 = (u.pn - C_GLU / BM) * 128 + wc * 16 + 4 * fq;
#pragma unroll
            for (int ai = 0; ai < 2; ++ai)
#pragma unroll
                for (int m = 0; m < 4; ++m) { const unsigned ro = (unsigned)(row0g + ai * HALF + m * 16) * 1024u + (unsigned)ch0;
#pragma unroll
                    for (int bj = 0; bj < 2; ++bj) { const f32x4 v0 = acc[ai][bj][m][0], v1 = acc[ai][bj][m][1];
                        u32x2 w; w.x = f2h_pk(v0[0] * sigmf(v0[1]), v0[2] * sigmf(v0[3])); w.y = f2h_pk(v1[0] * sigmf(v1[1]), v1[2] * sigmf(v1[3]));
                        *(u32x2*)(U + (ro + bj * 64)) = w; } }
            return; }
        if (u.pn < C_ML / BM) { EpiBf16 e; e.O = O; e.ldc = LDP; e(acc, u, wr, wc, fr, fq); return; }
        LAS unsigned* pad = xp + (wr * 4 + wc) * 256;
        const int row0 = u.pm * BM + wr * 64 + fr, d0 = (u.pn - C_ML / BM) * 64 + wc * 8;
#pragma unroll
        for (int ai = 0; ai < 2; ++ai)
#pragma unroll
            for (int m = 0; m < 4; ++m) { const unsigned ro = (unsigned)(row0 + ai * HALF + m * 16) * 8192u + (unsigned)(d0 + fq * 2048);
#pragma unroll
                for (int bj = 0; bj < 2; ++bj) { float rr[2][4];
#pragma unroll
                    for (int n = 0; n < 2; ++n) { float e[4];
#pragma unroll
                        for (int j = 0; j < 4; ++j) e[j] = 1.f + __expf(-fminf(fmaxf(acc[ai][bj][m][n][j], -30.f), 30.f));
                        rr[n][0] = fminf(e[1] * __builtin_amdgcn_rcpf(e[0]), 60000.f); rr[n][1] = fminf(e[2] * __builtin_amdgcn_rcpf(e[1]), 60000.f);
                        rr[n][2] = fminf(e[3] * __builtin_amdgcn_rcpf(e[2]), 60000.f); rr[n][3] = __builtin_amdgcn_rcpf(e[3]); }
#pragma unroll
                    for (int i = 0; i < 4; ++i) pad[(i * 16 + fr) * 4 + fq] = f2h_pk(rr[0][i], rr[1][i]);
                    asm volatile("s_waitcnt lgkmcnt(0)" ::: "memory");
                    const u32x4 w = *(const LAS u32x4*)(pad + (fq * 16 + fr) * 4);
                    asm volatile("s_waitcnt lgkmcnt(0)" ::: "memory");
                    *(u32x4*)(R + (ro + bj * 32)) = w; } }
    }
};
struct EpiPool {
    static constexpr bool PERM = true, MID = false;
    bf16_t* O; const float* scale; const bf16_t* gc;
    __device__ __forceinline__ void operator()(f32x4 (&acc)[2][2][4][2], const Unit& u, int wr, int wc, int fr, int fq) const {
        const int row0 = u.pm * BM + wr * 64 + fr, col0 = u.pn * BM + wc * 32 + 8 * fq;
#pragma unroll
        for (int bj = 0; bj < 2; ++bj) {
            const f32x4 s0 = *(const f32x4*)(scale + col0 + bj * HALF), s1 = *(const f32x4*)(scale + col0 + bj * HALF + 4);
            u32x4 gv[2][4];
#pragma unroll
            for (int ai = 0; ai < 2; ++ai)
#pragma unroll
                for (int m = 0; m < 4; ++m) gv[ai][m] = *(const u32x4*)(gc + ((unsigned)(row0 + ai * HALF + m * 16) * (unsigned)LDP + col0 + bj * HALF));
#pragma unroll
            for (int ai = 0; ai < 2; ++ai)
#pragma unroll
                for (int m = 0; m < 4; ++m) { const unsigned r = (unsigned)(row0 + ai * HALF + m * 16);
                    float gf[8]; UNPACK8(gv[ai][m], gf);
                    const f32x4 v0 = acc[ai][bj][m][0] * s0, v1 = acc[ai][bj][m][1] * s1;
                    u32x4 w;
                    w.x = cvt_pk_bf16(v0[0] * siluf(gf[0]), v0[1] * siluf(gf[1])); w.y = cvt_pk_bf16(v0[2] * siluf(gf[2]), v0[3] * siluf(gf[3]));
                    w.z = cvt_pk_bf16(v1[0] * siluf(gf[4]), v1[1] * siluf(gf[5])); w.w = cvt_pk_bf16(v1[2] * siluf(gf[6]), v1[3] * siluf(gf[7]));
                    *(u32x4*)(O + (r * 4096u + col0 + bj * HALF)) = w; }
            asm volatile("" ::: "memory"); }
    }
};
struct EpiRes {
    static constexpr bool PERM = false, MID = false;
    const float* xin0; const float* xin1; float* xo; const float* modl;
    __device__ __forceinline__ void operator()(f32x4 (&acc)[2][2][4][2], const Unit& u, int wr, int wc, int fr, int fq) const {
        const int row0 = u.pm * BM + wr * 64 + fr, col0 = u.pn * BM + wc * 32 + 4 * fq;
        const int ci = u.pm < 32 ? 0 : 1 + ((u.pm - 32) >> 2);
        const float* gate = modl + ci * 6144 + 4096;
        const float* xin = u.pm < 32 ? xin0 : xin1;
        f32x4 gv[2][2];
#pragma unroll
        for (int bj = 0; bj < 2; ++bj)
#pragma unroll
            for (int n = 0; n < 2; ++n) gv[bj][n] = *(const f32x4*)(gate + col0 + bj * HALF + n * 16);
#pragma unroll
        for (int ai = 0; ai < 2; ++ai) {
            f32x4 xv[4][2][2];
#pragma unroll
            for (int m = 0; m < 4; ++m)
#pragma unroll
                for (int bj = 0; bj < 2; ++bj)
#pragma unroll
                    for (int n = 0; n < 2; ++n) xv[m][bj][n] = *(const f32x4*)(xin + ((unsigned)(row0 + ai * HALF + m * 16) * 2048u + (unsigned)col0 + bj * HALF + n * 16));
#pragma unroll
            for (int m = 0; m < 4; ++m)
#pragma unroll
                for (int bj = 0; bj < 2; ++bj)
#pragma unroll
                    for (int n = 0; n < 2; ++n) *(f32x4*)(xo + ((unsigned)(row0 + ai * HALF + m * 16) * 2048u + (unsigned)col0 + bj * HALF + n * 16)) = xv[m][bj][n] + gv[bj][n] * acc[ai][bj][m][n];
            asm volatile("" ::: "memory"); }
    }
};
struct EpiMerge {
    static constexpr bool PERM = true, MID = true;
    const unsigned short* R; bf16_t* O;
    __device__ __forceinline__ void scale(f32x4 (&acc)[2][2][4][2], const Unit& u, int i, int wr, int wc, int fr, int fq) const {
        const int row0 = u.pm * BM + wr * 64 + fr, col0 = u.pn * BM + wc * 32 + 8 * fq;
        u32x4 av[2][4][2];
#pragma unroll
        for (int ai = 0; ai < 2; ++ai)
#pragma unroll
            for (int m = 0; m < 4; ++m)
#pragma unroll
                for (int bj = 0; bj < 2; ++bj) av[ai][m][bj] = *(const u32x4*)(R + ((unsigned)(row0 + ai * HALF + m * 16) * 8192u + (unsigned)(i * 2048 + col0 + bj * HALF)));
#pragma unroll
        for (int ai = 0; ai < 2; ++ai)
#pragma unroll
            for (int m = 0; m < 4; ++m)
#pragma unroll
                for (int bj = 0; bj < 2; ++bj) { const u32x4 v = av[ai][m][bj];
                    acc[ai][bj][m][0][0] *= h2f_lo(v.x); acc[ai][bj][m][0][1] *= h2f_hi(v.x); acc[ai][bj][m][0][2] *= h2f_lo(v.y); acc[ai][bj][m][0][3] *= h2f_hi(v.y);
                    acc[ai][bj][m][1][0] *= h2f_lo(v.z); acc[ai][bj][m][1][1] *= h2f_hi(v.z); acc[ai][bj][m][1][2] *= h2f_lo(v.w); acc[ai][bj][m][1][3] *= h2f_hi(v.w); }
        asm volatile("" ::: "memory");
    }
    __device__ __forceinline__ void mid(f32x4 (&acc)[2][2][4][2], const Unit& u, int tb, int wr, int wc, int fr, int fq) const { scale(acc, u, tb - 1, wr, wc, fr, fq); }
    __device__ __forceinline__ void operator()(f32x4 (&acc)[2][2][4][2], const Unit& u, int wr, int wc, int fr, int fq) const {
        scale(acc, u, 3, wr, wc, fr, fq);
        EpiBf16 e; e.O = O; e.ldc = 2048; e(acc, u, wr, wc, fr, fq);
    }
};
}

__device__ __forceinline__ void conv_jobs(const Params& p, unsigned char* shm, int job_lo, int job_hi, int nb, int bidx) {
    int tid_ = threadIdx.x; asm volatile("" : "+v"(tid_));
    const int tid = tid_, wid = tid >> 6, lane = tid & 63, G = nb;
    unsigned* L = (unsigned*)shm + wid * (64 * 33);
    int ubase = 0;
    for (int job = job_lo; job < job_hi; ++job) {
        const int l = job / 13, jj = job % 13;
        const float* src; int src_ld, dst_ld, N, K, mode = 0; bf16_t* dst;
        if (jj == 0) { src = p.in[8] + (size_t)l * 2048 * INC; src_ld = INC; dst = (bf16_t*)(p.ws + OFF_WIN + l * SZ_WIN1); dst_ld = 2048; N = NIN; K = 2048; mode = 1; }
        else if (jj <= 4) { const int i = jj - 1; src = p.in[21] + (size_t)(l * 4 + i) * 1024 * 2048; src_ld = 2048; dst = (bf16_t*)(p.ws + OFF_WBP + l * SZ_WBP1) + i * 1024; dst_ld = 4096; N = 2048; K = 1024; }
        else if (jj == 5) { src = p.in[22] + (size_t)l * 2048 * 2048; src_ld = 2048; dst = (bf16_t*)(p.ws + OFF_WOUT + l * SZ_WOUT1); dst_ld = 2048; N = 2048; K = 2048; }
        else if (jj == 6) { src = p.in[10] + (size_t)l * 512 * 1536; src_ld = 1536; dst = (bf16_t*)(p.ws + OFF_WQB + l * SZ_WQB1); dst_ld = 512; N = 1536; K = 512; }
        else if (jj == 7) { src = p.in[12] + (size_t)l * 256 * 2048; src_ld = 2048; dst = (bf16_t*)(p.ws + OFF_WK + l * SZ_WK1); dst_ld = 256; N = 1024; K = 256; mode = 2; }
        else if (jj == 8) { src = p.in[12] + (size_t)l * 256 * 2048; src_ld = 2048; dst = (bf16_t*)(p.ws + OFF_WV + l * SZ_WK1); dst_ld = 256; N = 1024; K = 256; mode = 3; }
        else { const int g = jj - 9; src = p.in[15] + (size_t)(l * 4 + g) * 256 * 256; src_ld = 256; dst = (bf16_t*)(p.ws + OFF_WPOOL + l * SZ_WPOOL1) + (size_t)g * 256 * 256; dst_ld = 256; N = 256; K = 256; }
        const int nkt = K >> 6, nunits = ((N >> 6) * nkt) >> 3;
        int first = (bidx - ubase) % G; if (first < 0) first += G;
        for (int u = first; u < nunits; u += G) {
            const int tile = u * 8 + wid, nt = tile / nkt, kt = tile - nt * nkt, n0 = nt * 64, k0 = kt * 64;
            int sc = n0;
            if (mode == 1) sc = n0 < 832 ? n0 : (n0 < 896 ? -1 : (n0 < 8064 ? n0 - 64 : (n0 < C_GLU ? -1 : (n0 < C_GD ? -3 : (n0 < C_ML ? n0 - 192 : -2)))));
            else if (mode == 2) sc = (n0 >> 7) * 256 + (n0 & 127);
            else if (mode == 3) sc = (n0 >> 7) * 256 + 128 + (n0 & 127);
            const int c4 = lane & 15, r = lane >> 4;
            if (sc == -2) {
                const unsigned o0 = (unsigned)(k0 + 2 * r) * (unsigned)src_ld + 11072u + (unsigned)(((n0 - C_ML) >> 2) + c4);
#pragma unroll
                for (int hf = 0; hf < 2; ++hf) {
                    float xa[4][4], xb[4][4];
#pragma unroll
                    for (int i2 = 0; i2 < 4; ++i2)
#pragma unroll
                        for (int j = 0; j < 4; ++j) { const int it = hf * 4 + i2; xa[i2][j] = __builtin_nontemporal_load(src + (o0 + (unsigned)(it * 8) * (unsigned)src_ld + j * 2048u)); xb[i2][j] = __builtin_nontemporal_load(src + (o0 + (unsigned)(it * 8 + 1) * (unsigned)src_ld + j * 2048u)); }
#pragma unroll
                    for (int i2 = 0; i2 < 4; ++i2)
#pragma unroll
                        for (int j = 0; j < 4; ++j) L[(4 * c4 + j) * 33 + (hf * 4 + i2) * 4 + r] = cvt_pk_bf16(xa[i2][j], xb[i2][j]);
                    asm volatile("" ::: "memory"); }
            } else if (sc == -3) {
                const unsigned o0 = (unsigned)(k0 + 2 * r) * (unsigned)src_ld + 8000u + (unsigned)(((n0 - C_GLU) >> 1) + 2 * c4);
#pragma unroll
                for (int hf = 0; hf < 2; ++hf) {
                    float xa[4][4], xb[4][4];
#pragma unroll
                    for (int i2 = 0; i2 < 4; ++i2)
#pragma unroll
                        for (int j = 0; j < 4; ++j) { const int it = hf * 4 + i2; const unsigned oc = (unsigned)((j & 1) * 1024 + (j >> 1));
                            xa[i2][j] = __builtin_nontemporal_load(src + (o0 + (unsigned)(it * 8) * (unsigned)src_ld + oc)); xb[i2][j] = __builtin_nontemporal_load(src + (o0 + (unsigned)(it * 8 + 1) * (unsigned)src_ld + oc)); }
#pragma unroll
                    for (int i2 = 0; i2 < 4; ++i2)
#pragma unroll
                        for (int j = 0; j < 4; ++j) L[(4 * c4 + j) * 33 + (hf * 4 + i2) * 4 + r] = cvt_pk_bf16(xa[i2][j], xb[i2][j]);
                    asm volatile("" ::: "memory"); }
            } else {
            f32x4 va[8], vb[8];
            if (sc >= 0) { const float* sp = src + (size_t)(k0 + 2 * r) * src_ld + sc + 4 * c4;
#pragma unroll
                for (int it = 0; it < 8; ++it) { va[it] = __builtin_nontemporal_load((const f32x4*)(sp + (size_t)(it * 8) * src_ld)); vb[it] = __builtin_nontemporal_load((const f32x4*)(sp + (size_t)(it * 8 + 1) * src_ld)); } }
            else {
#pragma unroll
                for (int it = 0; it < 8; ++it) { va[it] = (f32x4){0.f, 0.f, 0.f, 0.f}; vb[it] = (f32x4){0.f, 0.f, 0.f, 0.f}; } }
#pragma unroll
            for (int it = 0; it < 8; ++it)
#pragma unroll
                for (int j = 0; j < 4; ++j) L[(4 * c4 + j) * 33 + it * 4 + r] = cvt_pk_bf16(va[it][j], vb[it][j]);
            }
            __syncthreads();
#pragma unroll
            for (int ps = 0; ps < 8; ++ps) { const int n = ps * 8 + (lane >> 3), kw = (lane & 7) * 4;
                u32x4 o; o.x = L[n * 33 + kw]; o.y = L[n * 33 + kw + 1]; o.z = L[n * 33 + kw + 2]; o.w = L[n * 33 + kw + 3];
                *(u32x4*)(dst + (size_t)(n0 + n) * dst_ld + k0 + kw * 2) = o; }
            __syncthreads();
        }
        ubase = (ubase + nunits) % G;
    }
}

__device__ __forceinline__ void phase_prep(const Params& p, unsigned char* shm) {
    int tid_ = threadIdx.x; asm volatile("" : "+v"(tid_));
    const int tid = tid_, wid = tid >> 6, lane = tid & 63, G = gridDim.x;
    const float* c = p.in[3]; const float* c_ctx = p.in[4]; const float* w_ada = p.in[5]; const float* b_ada = p.in[6];
    float* mod = (float*)(p.ws + OFF_MOD);
    for (int u = blockIdx.x; u < 192; u += G) {
        const int l = u / 96, cc = u % 96;
        float* s = (float*)shm;
        for (int i = tid; i < 5 * 2048; i += 512) { const int ci = i >> 11, k = i & 2047; const float v = ci == 0 ? c_ctx[k] : c[(ci - 1) * 2048 + k]; s[i] = v / (1.f + expf(-v)); }
        __syncthreads();
        const float* w = w_ada + (size_t)l * 2048 * 6144 + cc * 64 + lane;
        float a0 = 0.f, a1 = 0.f, a2 = 0.f, a3 = 0.f, a4 = 0.f;
        const int kb = wid * 256;
#pragma unroll 32
        for (int k = kb; k < kb + 256; ++k) { const float wv = __builtin_nontemporal_load(w + (size_t)k * 6144); a0 += s[k] * wv; a1 += s[2048 + k] * wv; a2 += s[4096 + k] * wv; a3 += s[6144 + k] * wv; a4 += s[8192 + k] * wv; }
        float* red = (float*)(shm + 40960);
        red[(wid * 5 + 0) * 64 + lane] = a0; red[(wid * 5 + 1) * 64 + lane] = a1; red[(wid * 5 + 2) * 64 + lane] = a2; red[(wid * 5 + 3) * 64 + lane] = a3; red[(wid * 5 + 4) * 64 + lane] = a4;
        __syncthreads();
        if (tid < 320) { const int ci = tid >> 6; float r = 0.f;
#pragma unroll
            for (int w8 = 0; w8 < 8; ++w8) r += red[(w8 * 5 + ci) * 64 + lane];
            const int col = cc * 64 + lane; mod[(size_t)(l * 5 + ci) * 6144 + col] = r + b_ada[l * 6144 + col]; }
        __syncthreads();
    }
    conv_jobs(p, shm, 0, 13, G, blockIdx.x);
}

__device__ __forceinline__ void phase_norm(const Params& p, int l, int r_lo, int r_hi, int nb, int bidx) {
    int tid_ = threadIdx.x; asm volatile("" : "+v"(tid_));
    const int tid = tid_, wid = tid >> 6, lane = tid & 63, G = gridDim.x;
    const float* nw = p.in[7] + l * 2048;
    const float* mod = (const float*)(p.ws + OFF_MOD);
    const float* xres = (const float*)(p.ws + OFF_XRES);
    bf16_t* h = (bf16_t*)(p.ws + OFF_H);
    for (int r = r_lo + bidx * 8 + wid; r < r_hi; r += nb * 8) {
        const float* x = l == 0 ? (r < TC ? p.in[0] + (size_t)r * 2048 : p.in[1] + (size_t)(r - TC) * 2048) : xres + (size_t)r * 2048;
        const int ci = r < TC ? 0 : 1 + ((r - TC) >> 10);
        const float* md = mod + (size_t)(l * 5 + ci) * 6144;
        f32x4 v[8]; float ss = 0.f;
#pragma unroll
        for (int j = 0; j < 8; ++j) { v[j] = *(const f32x4*)(x + j * 256 + lane * 4); ss += v[j][0] * v[j][0] + v[j][1] * v[j][1] + v[j][2] * v[j][2] + v[j][3] * v[j][3]; }
        ss = wave_sum(ss, lane);
        const float rstd = 1.f / sqrtf(ss * (1.f / 2048.f) + EPS);
#pragma unroll
        for (int j = 0; j < 8; ++j) { const int cix = j * 256 + lane * 4;
            const f32x4 w4 = *(const f32x4*)(nw + cix), sh = *(const f32x4*)(md + cix), sc = *(const f32x4*)(md + 2048 + cix);
            const f32x4 y = v[j] * rstd * w4 * (sc + 1.f) + sh;
            u32x2 o; o.x = cvt_pk_bf16(y[0], y[1]); o.y = cvt_pk_bf16(y[2], y[3]);
            *(u32x2*)(h + (size_t)r * 2048 + cix) = o; }
    }
}

__device__ __forceinline__ void phase_final(const Params& p, int r_lo, int r_hi, int nb, int bidx) {
    int tid_ = threadIdx.x; asm volatile("" : "+v"(tid_));
    const int tid = tid_, wid = tid >> 6, lane = tid & 63, G = gridDim.x;
    const float* fw = p.in[23];
    const float* xres = (const float*)(p.ws + OFF_XRES);
    for (int r = r_lo + bidx * 8 + wid; r < r_hi; r += nb * 8) {
        const float* x = xres + (size_t)r * 2048;
        f32x4 v[8]; float ss = 0.f;
#pragma unroll
        for (int j = 0; j < 8; ++j) { v[j] = *(const f32x4*)(x + j * 256 + lane * 4); ss += v[j][0] * v[j][0] + v[j][1] * v[j][1] + v[j][2] * v[j][2] + v[j][3] * v[j][3]; }
        ss = wave_sum(ss, lane);
        const float rstd = 1.f / sqrtf(ss * (1.f / 2048.f) + EPS);
#pragma unroll
        for (int j = 0; j < 8; ++j) { const int cix = j * 256 + lane * 4; const f32x4 w4 = *(const f32x4*)(fw + cix);
            *(f32x4*)(p.out + (size_t)r * 2048 + cix) = v[j] * rstd * w4; }
    }
}

__device__ __forceinline__ void phase_elem(const Params& p, int l, unsigned char* shm) {
    int tid_ = threadIdx.x; asm volatile("" : "+v"(tid_));
    const int tid = tid_, wid = tid >> 6, lane = tid & 63, G = gridDim.x;
    const bf16_t* proj = (const bf16_t*)(p.ws + OFF_PROJ);
    bf16_t* qn = (bf16_t*)(p.ws + OFF_QN);
    bf16_t* kvall = (bf16_t*)(p.ws + OFF_KVALL);
    bf16_t* pooled = (bf16_t*)(p.ws + OFF_POOLED);
    bf16_t* ycat = (bf16_t*)(p.ws + OFF_YCAT);
    float* outc = p.out + (size_t)T * 2048;
    const bf16_t* ug = (const bf16_t*)(p.ws + OFF_U);
    { const float* cache = p.in[2];
      for (int i = blockIdx.x * 512 + tid; i < 4 * 256 * 320; i += G * 512) { const int j = i / (256 * 320), rem = i % (256 * 320), s = rem / 320, cc = rem % 320;
          const float v = cache[((size_t)(j * 2 + l) * 256 + s) * 320 + cc]; kvall[(size_t)(TC + j * 1280 + s) * 320 + cc] = (bf16_t)(cvt_pk_bf16(v, 0.f) & 0xffffu); } }
    const float* qnw = p.in[9] + l * 512; const float* kvnw = p.in[11] + l * 256;
    const float* c3w = p.in[13] + l * 3 * 1024; const float* c3b = p.in[14] + l * 1024;
    const float* dww = p.in[17] + l * 31 * 1024; const float* dwb = p.in[18] + l * 1024;
    const float* clw = p.in[19] + l * 1024; const float* clb = p.in[20] + l * 1024;
    for (int tile = blockIdx.x; tile < 768; tile += G) {
        const int t0 = tile * 16; const bool lat = t0 >= TC;
        const int s0 = lat ? TC + ((t0 - TC) & ~1023) : (t0 & ~255), s1 = s0 + (lat ? 1024 : 256);
#pragma unroll
        for (int i = 0; i < 2; ++i) {
            const int t = t0 + wid * 2 + i; const bf16_t* pr = proj + (size_t)t * LDP;
            { const u32x4 qv = *(const u32x4*)(pr + lane * 8); float f[8]; UNPACK8(qv, f);
              float ss = 0.f;
#pragma unroll
              for (int e = 0; e < 8; ++e) ss += f[e] * f[e];
              ss = wave_sum(ss, lane); const float rstd = 1.f / sqrtf(ss * (1.f / 512.f) + EPS);
              const f32x4 wa = *(const f32x4*)(qnw + lane * 8), wb = *(const f32x4*)(qnw + lane * 8 + 4);
              float o[8];
#pragma unroll
              for (int e = 0; e < 4; ++e) { o[e] = f[e] * rstd * wa[e]; o[4 + e] = f[4 + e] * rstd * wb[e]; }
              u32x4 w; PACK8(o, w); *(u32x4*)(qn + (size_t)t * 512 + lane * 8) = w; }
            { u32x4 kv = (u32x4){0u, 0u, 0u, 0u}; if (lane < 40) kv = *(const u32x4*)(pr + C_KVA + lane * 8);
              float g[8]; UNPACK8(kv, g);
              float ss = 0.f;
              if (lane < 32) {
#pragma unroll
                  for (int e = 0; e < 8; ++e) ss += g[e] * g[e]; }
              ss = wave_sum(ss, lane); const float rstd = 1.f / sqrtf(ss * (1.f / 256.f) + EPS);
              float pv[8];
#pragma unroll
              for (int e = 0; e < 8; ++e) pv[e] = swz_xor<2>(g[e]);
              float o[8];
              if (lane < 32) { const f32x4 wa = *(const f32x4*)(kvnw + lane * 8), wb = *(const f32x4*)(kvnw + lane * 8 + 4);
#pragma unroll
                  for (int e = 0; e < 4; ++e) { o[e] = g[e] * rstd * wa[e]; o[4 + e] = g[4 + e] * rstd * wb[e]; } }
              else if (lat && lane < 40) { const int q = lane - 32, tl = t - s0, axis = q >> 2, ib = (q & 1) * 8; const bool second = (q & 2) != 0;
                  const float pos = (float)(axis ? (tl & 63) : (tl >> 6));
#pragma unroll
                  for (int e = 0; e < 8; ++e) { const float ang = pos * rope_inv(ib + e); const float sn = __sinf(ang), cs = __cosf(ang);
                      o[e] = second ? g[e] * cs + pv[e] * sn : g[e] * cs - pv[e] * sn; } }
              else {
#pragma unroll
                  for (int e = 0; e < 8; ++e) o[e] = g[e]; }
              if (lane < 40) {
                  const int row = lat ? TC + ((t - TC) >> 10) * 1280 + 256 + (t - s0) : t;
                  u32x4 w; PACK8(o, w); *(u32x4*)(kvall + (size_t)row * 320 + lane * 8) = w;
                  if (!lat) { const int b = t >> 8, s = t & 255; float* oc = outc + ((size_t)(b * 2 + l) * 256 + s) * 320 + lane * 8;
                      *(f32x4*)oc = (f32x4){o[0], o[1], o[2], o[3]}; *(f32x4*)(oc + 4) = (f32x4){o[4], o[5], o[6], o[7]}; } } }
        }
        { const int cg8 = tid & 127, rsub = tid >> 7, c0 = cg8 * 8;
          float w0[8], w1[8], w2[8], bb[8];
#pragma unroll
          for (int e = 0; e < 8; ++e) { w0[e] = c3w[c0 + e]; w1[e] = c3w[1024 + c0 + e]; w2[e] = c3w[2048 + c0 + e]; bb[e] = c3b[c0 + e]; }
          const int grp = cg8 >> 5, win = 2 << grp;
#pragma unroll
          for (int ps = 0; ps < 8; ++ps) { const int rr = ps * 4 + rsub, t = t0 - 8 + rr; u32x4 o = (u32x4){0u, 0u, 0u, 0u};
              if (t >= s0 && t < s1) o = *(const u32x4*)(proj + (size_t)t * LDP + C_XP + c0);
              *(u32x4*)(shm + rr * 2048 + c0 * 2) = o; }
          __syncthreads();
#pragma unroll
          for (int ps = 0; ps < 4; ++ps) {
              const int t = t0 + ps * 4 + rsub; const bf16_t* pr = proj + (size_t)t * LDP;
              float pm[8], p0[8], pp[8];
              { const u32x4 a = *(const u32x4*)(pr + C_CG + c0), b = *(const u32x4*)(pr + C_XC + c0); float fa[8], fb[8]; UNPACK8(a, fa); UNPACK8(b, fb);
#pragma unroll
                for (int e = 0; e < 8; ++e) p0[e] = fa[e] * fb[e]; }
              if (t - 1 >= s0) { const u32x4 a = *(const u32x4*)(pr - LDP + C_CG + c0), b = *(const u32x4*)(pr - LDP + C_XC + c0); float fa[8], fb[8]; UNPACK8(a, fa); UNPACK8(b, fb);
#pragma unroll
                for (int e = 0; e < 8; ++e) pm[e] = fa[e] * fb[e]; }
              else {
#pragma unroll
                for (int e = 0; e < 8; ++e) pm[e] = 0.f; }
              if (t + 1 < s1) { const u32x4 a = *(const u32x4*)(pr + LDP + C_CG + c0), b = *(const u32x4*)(pr + LDP + C_XC + c0); float fa[8], fb[8]; UNPACK8(a, fa); UNPACK8(b, fb);
#pragma unroll
                for (int e = 0; e < 8; ++e) pp[e] = fa[e] * fb[e]; }
              else {
#pragma unroll
                for (int e = 0; e < 8; ++e) pp[e] = 0.f; }
              { const u32x4 a = *(const u32x4*)(pr + C_BG + c0), b = *(const u32x4*)(pr + C_GB + c0); float fa[8], fb[8]; UNPACK8(a, fa); UNPACK8(b, fb);
                float o[8];
#pragma unroll
                for (int e = 0; e < 8; ++e) o[e] = fa[e] * (w0[e] * pm[e] + w1[e] * p0[e] + w2[e] * pp[e] + bb[e]) * siluf(fb[e]);
                u32x4 w; PACK8(o, w); *(u32x4*)(ycat + (size_t)t * 4096 + 1024 + c0) = w; }
              { int lo = t - (win >> 1), hi = lo + win; const int lrow = t - t0 + 8 - (win >> 1); lo = lo < s0 ? s0 : lo; hi = hi > s1 ? s1 : hi;
                float sm[8];
#pragma unroll
                for (int e = 0; e < 8; ++e) sm[e] = 0.f;
#pragma unroll 4
                for (int j = 0; j < win; ++j) { const u32x4 a = *(const u32x4*)(shm + (lrow + j) * 2048 + c0 * 2); float fa[8]; UNPACK8(a, fa);
#pragma unroll
                    for (int e = 0; e < 8; ++e) sm[e] += fa[e]; }
                const u32x4 a = *(const u32x4*)(shm + (t - t0 + 8) * 2048 + c0 * 2); float fa[8]; UNPACK8(a, fa);
                const float inv = 1.f / (float)(hi - lo);
                float o[8];
#pragma unroll
                for (int e = 0; e < 8; ++e) o[e] = sm[e] * inv - fa[e];
                u32x4 w; PACK8(o, w); *(u32x4*)(pooled + (size_t)t * 1024 + c0) = w; }
          }
          __syncthreads(); }
        { const int cg8 = tid & 127, rsub = tid >> 7, c0 = cg8 * 8;
#pragma unroll
          for (int ps = 0; ps < 12; ++ps) { const int rr = ps * 4 + rsub;
              if (rr < 46) { const int t = t0 - 15 + rr; u32x4 o = (u32x4){0u, 0u, 0u, 0u};
                  if (t >= s0 && t < s1) o = *(const u32x4*)(ug + (size_t)t * 1024 + c0);
                  *(u32x4*)(shm + rr * 2048 + c0 * 2) = o; } }
          __syncthreads();
          const unsigned* ut = (const unsigned*)shm + tid;
          const f32x2 bv = *(const f32x2*)(dwb + 2 * tid);
          f32x2* red = (f32x2*)(shm + 126976);
          f32x2* stat = (f32x2*)(shm + 129024);
          float a0[16], a1[16];
#pragma unroll
          for (int t = 0; t < 16; ++t) { a0[t] = bv.x; a1[t] = bv.y; }
          f32x2 wc[4];
#pragma unroll
          for (int j = 0; j < 4; ++j) wc[j] = *(const f32x2*)(dww + j * 1024 + 2 * tid);
#pragma unroll 1
          for (int kg = 0; kg < 8; ++kg) {
              f32x2 wn[4];
#pragma unroll
              for (int j = 0; j < 4; ++j) { const int kn = kg * 4 + 4 + j; wn[j] = *(const f32x2*)(dww + (kn < 31 ? kn : 30) * 1024 + 2 * tid); }
#pragma unroll
              for (int j = 0; j < 4; ++j) { const int k = kg * 4 + j;
                  if (k < 31) { const unsigned* xr = ut + k * 512;
#pragma unroll
                      for (int t = 0; t < 16; ++t) { const unsigned uu = xr[t * 512]; fma_mix_lo(a0[t], wc[j].x, uu); fma_mix_hi(a1[t], wc[j].y, uu); } } }
#pragma unroll
              for (int j = 0; j < 4; ++j) wc[j] = wn[j];
          }
#pragma unroll
          for (int t = 0; t < 16; ++t) { float a = a0[t] + a1[t], b = a0[t] * a0[t] + a1[t] * a1[t]; a = wave_sum(a, lane); b = wave_sum(b, lane);
              if (lane == 0) red[t * 8 + wid] = (f32x2){a, b}; }
          __syncthreads();
          if (tid < 16) { float a = 0.f, b = 0.f;
#pragma unroll
              for (int w8 = 0; w8 < 8; ++w8) { const f32x2 r = red[tid * 8 + w8]; a += r.x; b += r.y; }
              const float mu = a * (1.f / 1024.f), var = fmaxf(b * (1.f / 1024.f) - mu * mu, 0.f); stat[tid] = (f32x2){mu, 1.f / sqrtf(var + EPS)}; }
          __syncthreads();
          const f32x2 cw = *(const f32x2*)(clw + 2 * tid), cb = *(const f32x2*)(clb + 2 * tid);
#pragma unroll
          for (int t = 0; t < 16; ++t) { const f32x2 st = stat[t];
              const unsigned gd = *(const unsigned*)(proj + ((unsigned)(t0 + t) * (unsigned)LDP + C_GD + 2 * tid));
              const float y0 = siluf((a0[t] - st.x) * st.y * cw.x + cb.x) * siluf(bf_lo(gd)), y1 = siluf((a1[t] - st.x) * st.y * cw.y + cb.y) * siluf(bf_hi(gd));
              *(unsigned*)(ycat + ((unsigned)(t0 + t) * 4096u + 3072 + 2 * tid)) = cvt_pk_bf16(y0, y1); }
          __syncthreads(); }
    }
}

__device__ __forceinline__ void phase_attn(const Params& p, int l, unsigned char* shm) {
    int tid_ = threadIdx.x; asm volatile("" : "+v"(tid_));
    const int tid = tid_, wid = tid >> 6, lane = tid & 63, G = gridDim.x, qr = lane & 15, kq = lane >> 4;
    const bf16_t* proj = (const bf16_t*)(p.ws + OFF_PROJ);
    const bf16_t* qb = (const bf16_t*)(p.ws + OFF_Q);
    const bf16_t* kvall = (const bf16_t*)(p.ws + OFF_KVALL);
    const bf16_t* knope = (const bf16_t*)(p.ws + OFF_KNOPE);
    const bf16_t* vt = (const bf16_t*)(p.ws + OFF_VT);
    bf16_t* ycat = (bf16_t*)(p.ws + OFF_YCAT);
    bf16_t* Qs = (bf16_t*)shm;
    bf16_t* Ks = (bf16_t*)(shm + 51200);
    bf16_t* Vs = (bf16_t*)(shm + 76800);
    const float cscale = 0.07216878364870322f * 1.4426950408889634f;
    for (int u = blockIdx.x; u < 768; u += G) {
        int h, tq, kr0, Lk, tl0; bool rope;
        if (u < 256) { const int j = u >> 6; h = (u >> 3) & 7; const int qblk = u & 7; tq = TC + j * 1024 + qblk * 128; kr0 = TC + j * 1280; Lk = 1280; rope = true; tl0 = qblk * 128; }
        else { const int v = u - 256, b = v >> 4; h = (v >> 1) & 7; const int qblk = v & 1; tq = b * 256 + qblk * 128; kr0 = b * 256; Lk = 256; rope = false; tl0 = 0; }
        __syncthreads();
#pragma unroll
        for (int ps = 0; ps < 4; ++ps) { const int id = ps * 512 + tid, r = id >> 4, c8 = id & 15;
            const u32x4 v = *(const u32x4*)(qb + (size_t)(tq + r) * 1536 + h * 192 + c8 * 8); *(u32x4*)(Qs + r * 200 + c8 * 8) = v; }
        { const int r = tid >> 2, axis = (tid >> 1) & 1, ig = tid & 1; const bf16_t* src = qb + (size_t)(tq + r) * 1536 + h * 192 + 128 + axis * 32 + ig * 8;
          u32x4 a = *(const u32x4*)src, b = *(const u32x4*)(src + 16);
          if (rope) { float x1[8], x2[8], y1[8], y2[8]; UNPACK8(a, x1); UNPACK8(b, x2); const int tl = tl0 + r; const float pos = (float)(axis ? (tl & 63) : (tl >> 6));
#pragma unroll
              for (int e = 0; e < 8; ++e) { const float ang = pos * rope_inv(ig * 8 + e); const float sn = __sinf(ang), cs = __cosf(ang); y1[e] = x1[e] * cs - x2[e] * sn; y2[e] = x2[e] * cs + x1[e] * sn; }
              PACK8(y1, a); PACK8(y2, b); }
          bf16_t* d = Qs + r * 200 + 128 + axis * 32 + ig * 8; *(u32x4*)d = a; *(u32x4*)(d + 16) = b; }
        bf16x8 qf[6];
        f32x4 o[8];
#pragma unroll
        for (int nb = 0; nb < 8; ++nb) o[nb] = (f32x4){0.f, 0.f, 0.f, 0.f};
        float m = -INFINITY, lsum = 0.f;
        u32x4 kreg[3], vreg[2];
#define ATT_LOAD(kc) do { \
            _Pragma("unroll") for (int ps = 0; ps < 3; ++ps) { const int id = ps * 512 + tid, r = id / 24, cc = id - r * 24; \
                const bf16_t* src = cc < 16 ? knope + (size_t)(kr0 + (kc) + r) * 1024 + h * 128 + cc * 8 : kvall + (size_t)(kr0 + (kc) + r) * 320 + 256 + (cc - 16) * 8; \
                kreg[ps] = *(const u32x4*)src; } \
            _Pragma("unroll") for (int ps = 0; ps < 2; ++ps) { const int id = ps * 512 + tid, d = id >> 3, c8 = id & 7; \
                vreg[ps] = *(const u32x4*)(vt + (size_t)(h * 128 + d) * KVR + kr0 + (kc) + c8 * 8); } } while (0)
#define ATT_STORE(Kb, Vb) do { \
            _Pragma("unroll") for (int ps = 0; ps < 3; ++ps) { const int id = ps * 512 + tid, r = id / 24, cc = id - r * 24; *(u32x4*)((Kb) + r * 200 + cc * 8) = kreg[ps]; } \
            _Pragma("unroll") for (int ps = 0; ps < 2; ++ps) { const int id = ps * 512 + tid, d = id >> 3, c8 = id & 7; *(u32x4*)((Vb) + d * 72 + c8 * 8) = vreg[ps]; } } while (0)
        bf16_t* const Ks1 = (bf16_t*)shm; bf16_t* const Vs1 = (bf16_t*)(shm + 25600);
        ATT_LOAD(0);
        ATT_STORE(Ks, Vs);
        __syncthreads();
#pragma unroll
        for (int c = 0; c < 6; ++c) qf[c] = *(const bf16x8*)(Qs + (wid * 16 + qr) * 200 + c * 32 + kq * 8);
        if (64 < Lk) ATT_LOAD(64);
        __syncthreads();
        for (int k0 = 0; k0 < Lk; k0 += 64) {
            const bool odd = (k0 & 64) != 0;
            const bf16_t* Kc = odd ? Ks1 : Ks; const bf16_t* Vc = odd ? Vs1 : Vs;
            if (k0 + 64 < Lk) { if (odd) ATT_STORE(Ks, Vs); else ATT_STORE(Ks1, Vs1); }
            if (k0 + 128 < Lk) ATT_LOAD(k0 + 128);
            f32x4 s[4];
#pragma unroll
            for (int kb = 0; kb < 4; ++kb) { s[kb] = (f32x4){0.f, 0.f, 0.f, 0.f};
#pragma unroll
                for (int c = 0; c < 6; ++c) { const bf16x8 kf = *(const bf16x8*)(Kc + (kb * 16 + qr) * 200 + c * 32 + kq * 8); s[kb] = __builtin_amdgcn_mfma_f32_16x16x32_bf16(kf, qf[c], s[kb], 0, 0, 0); } }
            float mx = s[0][0];
#pragma unroll
            for (int kb = 0; kb < 4; ++kb)
#pragma unroll
                for (int j = 0; j < 4; ++j) mx = fmaxf(mx, s[kb][j]);
            mx = fmaxf(mx, swz_xor<16>(mx)); mx = fmaxf(mx, bperm_xor32(mx, lane));
            const float mn = fmaxf(m, mx), alpha = __builtin_amdgcn_exp2f((m - mn) * cscale); m = mn;
            float psum = 0.f;
#pragma unroll
            for (int kb = 0; kb < 4; ++kb)
#pragma unroll
                for (int j = 0; j < 4; ++j) { const float e = __builtin_amdgcn_exp2f((s[kb][j] - mn) * cscale); s[kb][j] = e; psum += e; }
            lsum = lsum * alpha + psum;
#pragma unroll
            for (int nb = 0; nb < 8; ++nb) o[nb] *= alpha;
#pragma unroll
            for (int hb = 0; hb < 2; ++hb) {
                u32x4 pw; pw.x = cvt_pk_bf16(s[2 * hb][0], s[2 * hb][1]); pw.y = cvt_pk_bf16(s[2 * hb][2], s[2 * hb][3]); pw.z = cvt_pk_bf16(s[2 * hb + 1][0], s[2 * hb + 1][1]); pw.w = cvt_pk_bf16(s[2 * hb + 1][2], s[2 * hb + 1][3]);
                const bf16x8 pf = __builtin_bit_cast(bf16x8, pw);
#pragma unroll
                for (int nb = 0; nb < 8; ++nb) { const bf16_t* vp = Vc + (nb * 16 + qr) * 72 + hb * 32 + kq * 4;
                    const u32x2 lo = *(const u32x2*)vp, hi = *(const u32x2*)(vp + 16);
                    const u32x4 vw = (u32x4){lo.x, lo.y, hi.x, hi.y};
                    o[nb] = __builtin_amdgcn_mfma_f32_16x16x32_bf16(__builtin_bit_cast(bf16x8, vw), pf, o[nb], 0, 0, 0); } }
            __syncthreads();
        }
        float lt = lsum + swz_xor<16>(lsum); lt += bperm_xor32(lt, lane);
        const float inv = 1.f / lt;
        const int token = tq + wid * 16 + qr;
#pragma unroll
        for (int nb = 0; nb < 8; ++nb) { const int dv0 = nb * 16 + kq * 4;
            const u32x2 ga = *(const u32x2*)(proj + (size_t)token * LDP + C_GA + h * 128 + dv0);
            const float y0 = o[nb][0] * inv * siluf(bf_lo(ga.x)), y1 = o[nb][1] * inv * siluf(bf_hi(ga.x)), y2 = o[nb][2] * inv * siluf(bf_lo(ga.y)), y3 = o[nb][3] * inv * siluf(bf_hi(ga.y));
            u32x2 w; w.x = cvt_pk_bf16(y0, y1); w.y = cvt_pk_bf16(y2, y3);
            *(u32x2*)(ycat + (size_t)token * 4096 + h * 128 + dv0) = w; }
    }
}

#define XB_TMO      128
#define XB_XCNT(j)  (256  + 64 * (j))
#define XB_XSUB(j)  (1280 + 64 * (j))
#define XB_XGEN(j)  (2304 + 64 * (j))
#define XB_TOP      3328
#define XB_TOPGEN   3392
#define XB_SPIN_CAP (1u << 22)
__device__ __forceinline__ unsigned xb_ld(unsigned* p)              { return __hip_atomic_load(p, __ATOMIC_RELAXED, __HIP_MEMORY_SCOPE_AGENT); }
__device__ __forceinline__ unsigned xb_add(unsigned* p, unsigned v) { return __hip_atomic_fetch_add(p, v, __ATOMIC_RELAXED, __HIP_MEMORY_SCOPE_AGENT); }
__device__ __forceinline__ unsigned xb_xcc_id() { return (unsigned)__builtin_amdgcn_s_getreg((3 << 11) | 20) & 0xFu; }
#define XB_SPIN(cond, bar) do { unsigned _sp = 0; while (cond) { __builtin_amdgcn_s_sleep(1); \
    if ((++_sp & 255u) == 0u) { if (xb_ld(&(bar)[XB_TMO])) break; if (_sp > XB_SPIN_CAP) { atomicAdd(&(bar)[XB_TMO], 1u); break; } } } } while (0)
__device__ __forceinline__ void xcd_barrier_complete(unsigned* bar, unsigned x, unsigned& nloc, unsigned& nx) {
    const unsigned G = gridDim.x * gridDim.y * gridDim.z;
    unsigned sum, cnt, mine, sp = 0u;
    for (;;) {
        sum = 0u; cnt = 0u; mine = 0u;
#pragma unroll
        for (unsigned j = 0; j < 16; ++j) { const unsigned c = xb_ld(&bar[XB_XCNT(j)]); sum += c; cnt += (c > 0u) ? 1u : 0u; mine = (j == x) ? c : mine; }
        if (sum == G) break;
        __builtin_amdgcn_s_sleep(1);
        if ((++sp & 255u) == 0u) { if (xb_ld(&bar[XB_TMO])) break; if (sp > XB_SPIN_CAP) { atomicAdd(&bar[XB_TMO], 1u); break; } }
    }
    nloc = mine > 0u ? mine : 1u; nx = cnt > 0u ? cnt : 1u;
}
__device__ __forceinline__ void xcd_barrier(unsigned* bar, volatile LAS unsigned* st) {
    asm volatile("s_waitcnt vmcnt(0)" ::: "memory");
    __syncthreads();
    if (threadIdx.x == 0) {
        const unsigned x = xb_xcc_id();
        __builtin_amdgcn_s_waitcnt(0);
        unsigned nloc = st[0], nx = st[1];
        if (nloc == 0u) { xcd_barrier_complete(bar, x, nloc, nx); st[0] = nloc; st[1] = nx; }
        const unsigned old = xb_add(&bar[XB_XSUB(x)], 1u);
        const unsigned gen = old / nloc;
        if (old + 1u == (gen + 1u) * nloc) {
            __builtin_amdgcn_fence(__ATOMIC_RELEASE, "agent");
            asm volatile("s_waitcnt vmcnt(0)" ::: "memory");
            const unsigned og = xb_add(&bar[XB_TOP], 1u);
            const unsigned tg = og / nx;
            if (og + 1u == (tg + 1u) * nx) xb_add(&bar[XB_TOPGEN], 1u);
            else XB_SPIN(xb_ld(&bar[XB_TOPGEN]) == tg, bar);
            __builtin_amdgcn_fence(__ATOMIC_ACQUIRE, "agent");
            xb_add(&bar[XB_XGEN(x)], 1u);
            asm volatile("s_waitcnt vmcnt(0)" ::: "memory");
        } else {
            XB_SPIN(xb_ld(&bar[XB_XGEN(x)]) == gen, bar);
            __builtin_amdgcn_fence(__ATOMIC_ACQUIRE, "agent");
            asm volatile("s_waitcnt vmcnt(0)" ::: "memory");
        }
    }
    __syncthreads();
}

#define LAUNDER() \
        int z_ = 0; asm volatile("" : "+s"(z_)); \
        const __attribute__((address_space(4))) unsigned char* kp_ = (const __attribute__((address_space(4))) unsigned char*)__builtin_amdgcn_kernarg_segment_ptr(); \
        asm volatile("" : "+s"(kp_)); \
        const Params& p = *(const Params*)kp_; \
        LAS unsigned char* lds = lds0 + z_; \
        unsigned char* shm = (unsigned char*)lds; (void)shm; (void)lds; (void)p;
#define RUNPH(idx, ...) do { const int idx_ = (idx); if (idx_ >= ph_lo && idx_ < ph_hi) { { LAUNDER() __VA_ARGS__ } if (idx_ + 1 < ph_hi) { LAUNDER() xcd_barrier((unsigned*)(p.ws + OFF_BAR), (volatile LAS unsigned*)(lds0 + 131072)); } } } while (0)

template <int l> __device__ __forceinline__ void run_layer(cg::grid_group& grid, LAS unsigned char* lds0, int ph_lo, int ph_hi) {
        constexpr int pb = 1 + 8 * l;

        RUNPH(pb + 0, { if (l == 0) phase_norm(p, 0, 0, T, (int)gridDim.x, (int)blockIdx.x); else phase_norm(p, l, TC, T, (int)gridDim.x, (int)blockIdx.x); });
        RUNPH(pb + 1, {
            const int G = gridDim.x, bid = blockIdx.x;
            pg8::Gemm g; pg8::EpiWin e;
            g.A = (const bf16_t*)(p.ws + OFF_H); g.lda = 2048; g.Bt = (const bf16_t*)(p.ws + OFF_WIN + l * SZ_WIN1); g.ldb = 2048; g.M = T; g.N = NIN; g.K = 2048; e.O = (bf16_t*)(p.ws + OFF_PROJ); e.R = (unsigned short*)(p.ws + OFF_RAT); e.U = (bf16_t*)(p.ws + OFF_U); e.xp = (LAS unsigned*)(lds + LDS_XP);
            pg8::StaticOrder S; S.init(g.M, g.N, G, bid);
            pg8::gemm_phase<pg8::EpiWin>(lds, g, S, e);
            if (l == 0) { const int extra = S.nwg % G;
                if (extra > 0) { if (bid >= extra) conv_jobs(p, shm, 13, 26, G - extra, bid - extra); }
                else conv_jobs(p, shm, 13, 26, G, bid); } });
        RUNPH(pb + 2, phase_elem(p, l, shm););
        RUNPH(pb + 3, {
            const int G = gridDim.x, bid = blockIdx.x;
            int start = 0;
            { pg8::Gemm g; pg8::EpiBf16 e;
              g.A = (const bf16_t*)(p.ws + OFF_QN); g.lda = 512; g.Bt = (const bf16_t*)(p.ws + OFF_WQB + l * SZ_WQB1); g.ldb = 512; g.M = T; g.N = 1536; g.K = 512; e.O = (bf16_t*)(p.ws + OFF_Q); e.ldc = 1536;
              pg8::StaticOrder S; S.init(g.M, g.N, G, bid);
              pg8::gemm_phase<pg8::EpiBf16>(lds, g, S, e); start += S.nwg; }
            { LAUNDER()
              pg8::Gemm g; pg8::EpiBf16 e;
              g.A = (const bf16_t*)(p.ws + OFF_KVALL); g.lda = 320; g.Bt = (const bf16_t*)(p.ws + OFF_WK + l * SZ_WK1); g.ldb = 256; g.M = KVR; g.N = 1024; g.K = 256; e.O = (bf16_t*)(p.ws + OFF_KNOPE); e.ldc = 1024;
              pg8::StaticOrder S; S.init(g.M, g.N, G, (bid - start % G + G) % G);
              pg8::gemm_phase<pg8::EpiBf16>(lds, g, S, e); start += S.nwg; }
            { LAUNDER()
              pg8::Gemm g; pg8::EpiBf16 e;
              g.A = (const bf16_t*)(p.ws + OFF_WV + l * SZ_WK1); g.lda = 256; g.Bt = (const bf16_t*)(p.ws + OFF_KVALL); g.ldb = 320; g.M = 1024; g.N = KVR; g.K = 256; e.O = (bf16_t*)(p.ws + OFF_VT); e.ldc = KVR;
              pg8::StaticOrder S; S.init(g.M, g.N, G, (bid - start % G + G) % G);
              pg8::gemm_phase<pg8::EpiBf16>(lds, g, S, e); start += S.nwg; }
            { LAUNDER()
              const int G2 = gridDim.x;
              pg8::Gemm g; g.A = (const bf16_t*)(p.ws + OFF_POOLED); g.lda = 1024; g.a_pn = 256; g.Bt = (const bf16_t*)(p.ws + OFF_WPOOL + l * SZ_WPOOL1); g.ldb = 256; g.M = T; g.N = 1024; g.K = 256;
              pg8::EpiPool e; e.O = (bf16_t*)(p.ws + OFF_YCAT) + 2048; e.scale = p.in[16] + l * 1024; e.gc = (const bf16_t*)(p.ws + OFF_PROJ) + C_GC;
              pg8::StaticOrder S; S.init(g.M, g.N, G2, ((int)blockIdx.x + G2 - start % G2) % G2);
              pg8::gemm_phase<pg8::EpiPool>(lds, g, S, e); } });
        RUNPH(pb + 4, phase_attn(p, l, shm););
#define MK_MERGE_GEMM(Mrows, Gx, cx, pmo) do { \
            pg8::Gemm g; g.A = (const bf16_t*)(p.ws + OFF_YCAT); g.lda = 4096; g.Bt = (const bf16_t*)(p.ws + OFF_WBP + l * SZ_WBP1); g.ldb = 4096; g.M = (Mrows); g.N = 2048; g.K = 4096; \
            pg8::EpiMerge e; e.R = (const unsigned short*)(p.ws + OFF_RAT); e.O = (bf16_t*)(p.ws + OFF_MERGED); \
            pg8::StaticOrder S; S.init(g.M, g.N, (Gx), (cx), (pmo)); \
            pg8::gemm_phase<pg8::EpiMerge>(lds, g, S, e); } while (0)
#define MK_OUT_GEMM(Mrows, Gx, cx, pmo) do { \
            pg8::Gemm g; g.A = (const bf16_t*)(p.ws + OFF_MERGED); g.lda = 2048; g.Bt = (const bf16_t*)(p.ws + OFF_WOUT + l * SZ_WOUT1); g.ldb = 2048; g.M = (Mrows); g.N = 2048; g.K = 2048; \
            pg8::EpiRes e; float* xres = (float*)(p.ws + OFF_XRES); \
            e.xin0 = l == 0 ? p.in[0] : xres; e.xin1 = l == 0 ? p.in[1] - (size_t)TC * 2048 : xres; e.xo = xres; e.modl = (const float*)(p.ws + OFF_MOD) + (size_t)l * 5 * 6144; \
            pg8::StaticOrder S; S.init(g.M, g.N, (Gx), (cx), (pmo)); \
            pg8::gemm_phase<pg8::EpiRes>(lds, g, S, e); } while (0)
        RUNPH(pb + 5, { MK_MERGE_GEMM(8192, (int)gridDim.x, (int)blockIdx.x, 0); });
        RUNPH(pb + 6, { const int G = gridDim.x, bid = blockIdx.x, hg = G / 2;
            if (bid < hg) MK_MERGE_GEMM(4096, hg, bid, 32);
            else MK_OUT_GEMM(8192, G - hg, bid - hg, 0); });
        RUNPH(pb + 7, { const int G = gridDim.x, bid = blockIdx.x, hg = G / 2;
            if (bid < hg) MK_OUT_GEMM(4096, hg, bid, 32);
            else if (l == 0) phase_norm(p, 1, 0, TC, G - hg, bid - hg);
            else phase_final(p, 0, TC, G - hg, bid - hg); });
}

__global__ __launch_bounds__(512, 2) void mega(Params p_arg) {
    extern __shared__ __attribute__((aligned(16))) unsigned char shm0[];
    LAS unsigned char* lds0 = (LAS unsigned char*)shm0;
    cg::grid_group grid = cg::this_grid();
    const int ph_lo = p_arg.ph_lo, ph_hi = p_arg.ph_hi;
    if (ph_hi < 0) grid.sync();
    { volatile LAS unsigned* st = (volatile LAS unsigned*)(lds0 + 131072);
      if (threadIdx.x == 0) { st[0] = 0u; st[1] = 0u; st[2] = 0u; st[3] = 0u; }
      __syncthreads();
      if (threadIdx.x == 0) (void)xb_add(&((unsigned*)(p_arg.ws + OFF_BAR))[XB_XCNT(xb_xcc_id())], 1u); }
    RUNPH(0, phase_prep(p, shm););
    run_layer<0>(grid, lds0, ph_lo, ph_hi);
    run_layer<1>(grid, lds0, ph_lo, ph_hi);
    RUNPH(NPHASE - 1, phase_final(p, TC, T, (int)gridDim.x, (int)blockIdx.x););
}

#ifndef MK_PER_PHASE
#define MK_PER_PHASE 0
#endif

extern "C" void kernel_launch(void* const* d_in, const int* in_sizes, int n_in, void* d_out, int out_size, void* d_ws, size_t ws_size, hipStream_t stream) {
    static int grid = 0;
    if (grid == 0) {
        int dev = 0, cus = 0, per_cu = 0;
        hipGetDevice(&dev);
        hipDeviceGetAttribute(&cus, hipDeviceAttributeMultiprocessorCount, dev);
        if (hipFuncSetAttribute((const void*)mega, hipFuncAttributeMaxDynamicSharedMemorySize, LDS_BYTES) != hipSuccess) { fprintf(stderr, "hipFuncSetAttribute failed\n"); }
        if (hipOccupancyMaxActiveBlocksPerMultiprocessor(&per_cu, (const void*)mega, 512, LDS_BYTES) != hipSuccess || per_cu < 1) { fprintf(stderr, "occupancy query: %d\n", per_cu); per_cu = 1; }
        (void)hipGetLastError();
        grid = cus * 1;
        if (ws_size < WS_END) { fprintf(stderr, "workspace too small: %zu < %zu\n", ws_size, (size_t)WS_END); grid = -1; }
    }
    if (grid < 0) return;
    if (hipMemsetAsync((char*)d_ws + OFF_BAR, 0, BAR_BYTES, stream) != hipSuccess) { fprintf(stderr, "memset of barrier words failed\n"); return; }
    Params p{};
    for (int i = 0; i < 24; ++i) p.in[i] = (const float*)d_in[i];
    p.out = (float*)d_out; p.ws = (unsigned char*)d_ws;
#if MK_PER_PHASE
    for (int ph = 0; ph < NPHASE; ++ph) { p.ph_lo = ph; p.ph_hi = ph + 1; hipLaunchKernelGGL(mega, dim3(grid), dim3(512), LDS_BYTES, stream, p); }
#else
    p.ph_lo = 0; p.ph_hi = NPHASE;
    void* args[] = {&p};
    hipError_t e = hipLaunchCooperativeKernel((const void*)mega, dim3(grid), dim3(512), args, LDS_BYTES, stream);
    if (e != hipSuccess) fprintf(stderr, "cooperative launch failed: %s (grid %d)\n", hipGetErrorString(e), grid);
#endif
}
```

```cpp
#include <hip/hip_runtime.h>
#include <hip/hip_cooperative_groups.h>
#include <cstdio>
namespace cg = cooperative_groups;

#define LAS __attribute__((address_space(3)))
typedef unsigned short bf16_t;
typedef short bf16x8 __attribute__((ext_vector_type(8)));
typedef float f32x4 __attribute__((ext_vector_type(4)));
typedef float f32x2 __attribute__((ext_vector_type(2)));
typedef unsigned u32x4 __attribute__((ext_vector_type(4)));
typedef unsigned u32x2 __attribute__((ext_vector_type(2)));

constexpr int T = 12288, TC = 8192, DM = 2048, BW = 1024, LDP = 11264, NIN = 19456, KVR = 13312, INC = 19264;
constexpr int C_KVA = 512, C_GA = 896, C_BG = 1920, C_CG = 2944, C_XC = 3968, C_GB = 4992, C_XP = 6016, C_GC = 7040, C_GLU = 8192, C_GD = 10240, C_ML = 11264;
constexpr float EPS = 1e-6f;
constexpr int LDS_XP = 131072 + 16;
constexpr int LDS_BYTES = 131072 + 16 + 8192;
constexpr int NPHASE = 18;

constexpr size_t SZ_WIN1 = (size_t)NIN * 2048 * 2;
constexpr size_t SZ_WBP1 = (size_t)2048 * 4096 * 2;
constexpr size_t SZ_WOUT1 = (size_t)2048 * 2048 * 2;
constexpr size_t SZ_WQB1 = (size_t)1536 * 512 * 2;
constexpr size_t SZ_WK1 = (size_t)1024 * 256 * 2;
constexpr size_t SZ_WPOOL1 = (size_t)4 * 256 * 256 * 2;
constexpr size_t OFF_WIN = 0;
constexpr size_t OFF_WBP = OFF_WIN + 2 * SZ_WIN1;
constexpr size_t OFF_WOUT = OFF_WBP + 2 * SZ_WBP1;
constexpr size_t OFF_WQB = OFF_WOUT + 2 * SZ_WOUT1;
constexpr size_t OFF_WK = OFF_WQB + 2 * SZ_WQB1;
constexpr size_t OFF_WV = OFF_WK + 2 * SZ_WK1;
constexpr size_t OFF_WPOOL = OFF_WV + 2 * SZ_WK1;
constexpr size_t OFF_MOD = OFF_WPOOL + 2 * SZ_WPOOL1;
constexpr size_t OFF_H = OFF_MOD + (size_t)2 * 5 * 6144 * 4;
constexpr size_t OFF_PROJ = OFF_H + (size_t)T * 2048 * 2;
constexpr size_t OFF_QN = OFF_PROJ + (size_t)T * LDP * 2;
constexpr size_t OFF_KVALL = OFF_QN + (size_t)T * 512 * 2;
constexpr size_t OFF_POOLED = OFF_KVALL + (size_t)KVR * 320 * 2;
constexpr size_t OFF_YCAT = OFF_POOLED + (size_t)T * 1024 * 2;
constexpr size_t OFF_Q = OFF_YCAT + (size_t)T * 4096 * 2;
constexpr size_t OFF_KNOPE = OFF_Q + (size_t)T * 1536 * 2;
constexpr size_t OFF_VT = OFF_KNOPE + (size_t)KVR * 1024 * 2;
constexpr size_t OFF_MERGED = OFF_VT + (size_t)KVR * 1024 * 2;
constexpr size_t OFF_XRES = OFF_MERGED + (size_t)T * 2048 * 2;
constexpr size_t OFF_RAT = OFF_XRES + (size_t)T * 2048 * 4;
constexpr size_t OFF_U = OFF_RAT + (size_t)T * 8192 * 2;
constexpr size_t OFF_BAR = OFF_U + (size_t)T * 1024 * 2;
constexpr size_t BAR_BYTES = 16384;
constexpr size_t WS_END = OFF_BAR + BAR_BYTES;

struct Params {
    const float* in[24];
    float* out;
    unsigned char* ws;
    int ph_lo, ph_hi;
};

typedef float f32x2v __attribute__((ext_vector_type(2)));
typedef __bf16 bf16x2v __attribute__((ext_vector_type(2)));
__device__ __forceinline__ unsigned cvt_pk_bf16(float lo, float hi) { const f32x2v v = {lo, hi}; const bf16x2v r = __builtin_convertvector(v, bf16x2v); return __builtin_bit_cast(unsigned, r); }
__device__ __forceinline__ float bf_lo(unsigned u) { return __uint_as_float(u << 16); }
__device__ __forceinline__ float bf_hi(unsigned u) { return __uint_as_float(u & 0xffff0000u); }
__device__ __forceinline__ float siluf(float x) { return x * __builtin_amdgcn_rcpf(1.f + __expf(-x)); }
__device__ __forceinline__ float sigmf(float x) { return __builtin_amdgcn_rcpf(1.f + __expf(-x)); }
template <int O> __device__ __forceinline__ float swz_xor(float v) { return __int_as_float(__builtin_amdgcn_ds_swizzle(__float_as_int(v), (O << 10) | 0x1f)); }
__device__ __forceinline__ float bperm_xor32(float v, int lane) { return __int_as_float(__builtin_amdgcn_ds_bpermute((lane ^ 32) << 2, __float_as_int(v))); }
__device__ __forceinline__ float wave_sum(float v, int lane) {
    v += bperm_xor32(v, lane); v += swz_xor<16>(v); v += swz_xor<8>(v); v += swz_xor<4>(v); v += swz_xor<2>(v); v += swz_xor<1>(v);
    return v;
}
#define UNPACK8(v, f) do { f[0] = bf_lo(v.x); f[1] = bf_hi(v.x); f[2] = bf_lo(v.y); f[3] = bf_hi(v.y); f[4] = bf_lo(v.z); f[5] = bf_hi(v.z); f[6] = bf_lo(v.w); f[7] = bf_hi(v.w); } while (0)
#define PACK8(f, v) do { v.x = cvt_pk_bf16(f[0], f[1]); v.y = cvt_pk_bf16(f[2], f[3]); v.z = cvt_pk_bf16(f[4], f[5]); v.w = cvt_pk_bf16(f[6], f[7]); } while (0)
__device__ __forceinline__ void fma_mix_lo(float& acc, float w, unsigned x) { asm("v_fma_mix_f32 %0, %1, %2, %0 op_sel:[0,0,0] op_sel_hi:[0,1,0]" : "+v"(acc) : "v"(w), "v"(x)); }
__device__ __forceinline__ void fma_mix_hi(float& acc, float w, unsigned x) { asm("v_fma_mix_f32 %0, %1, %2, %0 op_sel:[0,1,0] op_sel_hi:[0,1,0]" : "+v"(acc) : "v"(w), "v"(x)); }
__device__ __forceinline__ float rope_inv(int i) { return __expf(-(float)i * 0.5756462732485114f); }

namespace pg8 {
constexpr int BM = 256, BK = 64, HALF = 128, HTB = HALF * BK * 2, NXCD = 8, WGM = 8;
__device__ __forceinline__ int lds_byte(int r, int c) { const int st = (r >> 4) * 2 + (c >> 5), rr = r & 15, cc = c & 31, ob = rr * 64 + cc * 2; return st * 1024 + (ob ^ (((ob >> 9) & 1) << 5)); }
__device__ __forceinline__ void stage_rc(int b, int& R, int& C) { const int st = b / 1024, sb = b % 1024, swz = sb ^ (((sb >> 9) & 1) << 5); R = (st >> 1) * 16 + swz / 64; C = (st & 1) * 32 + (swz % 64) / 2; }
__device__ __forceinline__ int perm32(int rho) { const int n = rho >> 4, i = rho & 15; return 8 * (i >> 2) + 4 * n + (i & 3); }
struct Unit { int pm, pn; };
struct Gemm { const bf16_t* A; const bf16_t* Bt; int M, N, K, lda, ldb; int a_pn = 0; };
struct StaticOrder {
    int nM, nN, nwg, G, c, pm_off;
    __device__ void init(int M, int N, int G_, int c_, int pm_off_ = 0) { nM = M / BM; nN = N / BM; nwg = nM * nN; G = G_; c = c_; pm_off = pm_off_; }
    __device__ bool next(int i, Unit& u) const {
        const long L = (long)i * G + c; if (L >= nwg) return false;
        int wgid = (int)L; { const int q = nwg / NXCD, r = nwg % NXCD, xcd = wgid % NXCD, off = wgid / NXCD; wgid = (xcd < r ? xcd * (q + 1) : r * (q + 1) + (xcd - r) * q) + off; }
        const int nig = WGM * nN, gid = wgid / nig, fm = gid * WGM, gsz = (nM - fm) < WGM ? (nM - fm) : WGM;
        u.pm = pm_off + fm + ((wgid % nig) % gsz); u.pn = (wgid % nig) / gsz; return true;
    }
};
template <class Epi>
__device__ __forceinline__ void gemm_phase(LAS unsigned char* lds, const Gemm g, const StaticOrder& S, const Epi& E) {
    int tid_ = threadIdx.x; asm volatile("" : "+v"(tid_));
    const int tid = tid_, wid = __builtin_amdgcn_readfirstlane(tid >> 6), lane = tid & 63, wr = wid >> 2, wc = wid & 3, fr = lane & 15, fq = lane >> 4;
    const int K = g.K, nt = K / BK;
    unsigned voffA[2], voffB[2];
#pragma unroll
    for (int i = 0; i < 2; ++i) { int R, C; stage_rc(tid * 16 + i * 8192, R, C); const int Rb = Epi::PERM ? ((R & ~31) + perm32(R & 31)) : R;
        voffA[i] = (unsigned)(R * g.lda + C) * 2u; voffB[i] = (unsigned)(Rb * g.ldb + C) * 2u; }
    const size_t kstep = (size_t)(BK * 2);
    const size_t hstepA = (size_t)HALF * g.lda * 2, hstepB = (size_t)HALF * g.ldb * 2;
    const size_t tstepA = 2 * hstepA, tstepB = 2 * hstepB;
    const unsigned ldsw = (unsigned)wid * 1024u;
    const int aoff = lds_byte(wr * 64 + fr, fq * 8), boff = lds_byte(wc * 32 + fr, fq * 8);
#define PG8_SA(b, h) (((b) * 2 + (h)) * HTB)
#define PG8_SB(b, h) ((4 + (b) * 2 + (h)) * HTB)
#define PG8_STAGE(bufoff, gbase, voff) do { const char* _gb = (const char*)(gbase); asm volatile("" : "+s"(_gb)); _Pragma("unroll") for (int _i = 0; _i < 2; ++_i) \
        __builtin_amdgcn_global_load_lds((const unsigned*)(_gb + (voff)[_i]), (LAS unsigned*)(lds + (bufoff) + ldsw + _i * 8192), 16, 0, 0); } while (0)
#define PG8_LDA(dst, b, h) do { _Pragma("unroll") for (int m = 0; m < 4; ++m) _Pragma("unroll") for (int k = 0; k < 2; ++k) dst[m][k] = *(const LAS bf16x8*)(lds + PG8_SA(b, h) + aoff + m * 2048 + k * 1024); } while (0)
#define PG8_LDB(dst, b, h) do { _Pragma("unroll") for (int n = 0; n < 2; ++n) _Pragma("unroll") for (int k = 0; k < 2; ++k) dst[n][k] = *(const LAS bf16x8*)(lds + PG8_SB(b, h) + boff + n * 2048 + k * 1024); } while (0)
#define PG8_MMA(ai, bj, At, Bt) do { __builtin_amdgcn_s_setprio(1); _Pragma("unroll") for (int m = 0; m < 4; ++m) _Pragma("unroll") for (int n = 0; n < 2; ++n) _Pragma("unroll") for (int k = 0; k < 2; ++k) \
        acc[ai][bj][m][n] = __builtin_amdgcn_mfma_f32_16x16x32_bf16(Bt[n][k], At[m][k], acc[ai][bj][m][n], 0, 0, 0); __builtin_amdgcn_s_setprio(0); } while (0)
#define PG8_WAIT_V(n) asm volatile("s_waitcnt vmcnt(" #n ")" ::: "memory")
#define PG8_WAIT_L(n) asm volatile("s_waitcnt lgkmcnt(" #n ")" ::: "memory")
#define PG8_BAR __builtin_amdgcn_s_barrier()
#define PG8_SCHED __builtin_amdgcn_sched_barrier(0)
    Unit cur, nxt; int ui = 0;
    if (!S.next(0, cur)) return;
    const char* cA = (const char*)g.A + (size_t)cur.pm * tstepA + (size_t)(cur.pn * g.a_pn) * 2; const char* cB = (const char*)g.Bt + (size_t)cur.pn * tstepB;
    PG8_STAGE(PG8_SB(0, 0), cB, voffB); PG8_STAGE(PG8_SA(0, 0), cA, voffA); PG8_STAGE(PG8_SB(0, 1), cB + hstepB, voffB); PG8_STAGE(PG8_SA(0, 1), cA + hstepA, voffA);
    if (wr == 1) PG8_BAR;
    PG8_WAIT_V(4); PG8_BAR;
    PG8_STAGE(PG8_SB(1, 0), cB + kstep, voffB); PG8_STAGE(PG8_SA(1, 0), cA + kstep, voffA); PG8_STAGE(PG8_SB(1, 1), cB + hstepB + kstep, voffB);
    PG8_WAIT_V(6); PG8_BAR;
    f32x4 acc[2][2][4][2];
#pragma unroll
    for (int a = 0; a < 2; ++a)
#pragma unroll
        for (int b = 0; b < 2; ++b)
#pragma unroll
            for (int m = 0; m < 4; ++m)
#pragma unroll
                for (int n = 0; n < 2; ++n) acc[a][b][m][n] = (f32x4){0.f, 0.f, 0.f, 0.f};
    bf16x8 At[4][2], B0[2][2], B1[2][2];
    for (;;) {
        const bool has_next = S.next(ui + 1, nxt);
        const char* nA = has_next ? (const char*)g.A + (size_t)nxt.pm * tstepA + (size_t)(nxt.pn * g.a_pn) * 2 : cA; const char* nB = has_next ? (const char*)g.Bt + (size_t)nxt.pn * tstepB : cB;
        for (int t = 0; t < nt; t += 2) {
            const bool last = (t == nt - 2);
            const char* a1 = cA + (size_t)(t + 1) * kstep;
            const char* a2 = last ? nA : cA + (size_t)(t + 2) * kstep; const char* b2 = last ? nB : cB + (size_t)(t + 2) * kstep;
            const char* a3 = a2 + kstep; const char* b3 = b2 + kstep;
            if constexpr (Epi::MID) { if (t != 0 && (t & 15) == 0) E.mid(acc, cur, t >> 4, wr, wc, fr, fq); }
            PG8_LDB(B0, 0, 0); PG8_SCHED; PG8_LDA(At, 0, 0); PG8_STAGE(PG8_SA(1, 1), a1 + hstepA, voffA);
            PG8_WAIT_L(8); PG8_BAR; PG8_WAIT_L(0); PG8_MMA(0, 0, At, B0); PG8_BAR; PG8_SCHED;
            PG8_LDB(B1, 0, 1); PG8_STAGE(PG8_SB(0, 0), b2, voffB);
            PG8_BAR; PG8_WAIT_L(0); PG8_MMA(0, 1, At, B1); PG8_BAR;
            PG8_LDA(At, 0, 1); PG8_STAGE(PG8_SA(0, 0), a2, voffA);
            PG8_BAR; PG8_WAIT_L(0); PG8_MMA(1, 0, At, B0); PG8_BAR; PG8_SCHED;
            PG8_STAGE(PG8_SB(0, 1), b2 + hstepB, voffB);
            PG8_WAIT_V(6); PG8_BAR; PG8_MMA(1, 1, At, B1); PG8_BAR;
            PG8_LDB(B0, 1, 0); PG8_SCHED; PG8_LDA(At, 1, 0); PG8_STAGE(PG8_SA(0, 1), a2 + hstepA, voffA);
            PG8_WAIT_L(8); PG8_BAR; PG8_WAIT_L(0); PG8_MMA(0, 0, At, B0); PG8_BAR; PG8_SCHED;
            PG8_LDB(B1, 1, 1); PG8_STAGE(PG8_SB(1, 0), b3, voffB);
            PG8_BAR; PG8_WAIT_L(0); PG8_MMA(0, 1, At, B1); PG8_BAR;
            PG8_LDA(At, 1, 1); PG8_STAGE(PG8_SA(1, 0), a3, voffA);
            PG8_BAR; PG8_WAIT_L(0); PG8_MMA(1, 0, At, B0); PG8_BAR; PG8_SCHED;
            PG8_STAGE(PG8_SB(1, 1), b3 + hstepB, voffB);
            PG8_WAIT_V(6); PG8_BAR; PG8_MMA(1, 1, At, B1); PG8_BAR;
        }
        E(acc, cur, wr, wc, fr, fq);
        if (!has_next) break;
#pragma unroll
        for (int a = 0; a < 2; ++a)
#pragma unroll
            for (int b = 0; b < 2; ++b)
#pragma unroll
                for (int m = 0; m < 4; ++m)
#pragma unroll
                    for (int n = 0; n < 2; ++n) acc[a][b][m][n] = (f32x4){0.f, 0.f, 0.f, 0.f};
        cur = nxt; cA = nA; cB = nB; ++ui;
    }
    PG8_WAIT_V(0);
    if (wr == 0) PG8_BAR;
    PG8_BAR;
#undef PG8_SA
#undef PG8_SB
#undef PG8_STAGE
#undef PG8_LDA
#undef PG8_LDB
#undef PG8_MMA
#undef PG8_WAIT_V
#undef PG8_WAIT_L
#undef PG8_BAR
#undef PG8_SCHED
}

struct EpiBf16 {
    static constexpr bool PERM = true, MID = false;
    bf16_t* O; int ldc;
    __device__ __forceinline__ void operator()(f32x4 (&acc)[2][2][4][2], const Unit& u, int wr, int wc, int fr, int fq) const {
        const int row0 = u.pm * BM + wr * 64 + fr, col0 = u.pn * BM + wc * 32 + 8 * fq;
#pragma unroll
        for (int ai = 0; ai < 2; ++ai)
#pragma unroll
            for (int m = 0; m < 4; ++m) { const unsigned ro = (unsigned)(row0 + ai * HALF + m * 16) * (unsigned)ldc + (unsigned)col0;
#pragma unroll
                for (int bj = 0; bj < 2; ++bj) { const f32x4 v0 = acc[ai][bj][m][0], v1 = acc[ai][bj][m][1];
                    u32x4 w; w.x = cvt_pk_bf16(v0[0], v0[1]); w.y = cvt_pk_bf16(v0[2], v0[3]); w.z = cvt_pk_bf16(v1[0], v1[1]); w.w = cvt_pk_bf16(v1[2], v1[3]);
                    *(u32x4*)(O + (ro + bj * HALF)) = w; } }
    }
};
__device__ __forceinline__ float h2f_lo(unsigned u) { return (float)__builtin_bit_cast(_Float16, (unsigned short)(u & 0xffffu)); }
__device__ __forceinline__ float h2f_hi(unsigned u) { return (float)__builtin_bit_cast(_Float16, (unsigned short)(u >> 16)); }
__device__ __forceinline__ unsigned f2h_pk(float a, float b) { return (unsigned)__builtin_bit_cast(unsigned short, (_Float16)a) | ((unsigned)__builtin_bit_cast(unsigned short, (_Float16)b) << 16); }
struct EpiWin {
    static constexpr bool PERM = true, MID = false;
    bf16_t* O; unsigned short* R; bf16_t* U; LAS unsigned* xp;
    __device__ __forceinline__ void operator()(f32x4 (&acc)[2][2][4][2], const Unit& u, int wr, int wc, int fr, int fq) const {
        if (u.pn >= C_GLU / BM && u.pn < C_GD / BM) {
            const int row0g = u.pm * BM + wr * 64 + fr, ch0 = (u.pn - C_GLU / BM) * 128 + wc * 16 + 4 * fq;
#pragma unroll
            for (int ai = 0; ai < 2; ++ai)
#pragma unroll
                for (int m = 0; m < 4; ++m) { const unsigned ro = (unsigned)(row0g + ai * HALF + m * 16) * 1024u + (unsigned)ch0;
#pragma unroll
                    for (int bj = 0; bj < 2; ++bj) { const f32x4 v0 = acc[ai][bj][m][0], v1 = acc[ai][bj][m][1];
                        u32x2 w; w.x = f2h_pk(v0[0] * sigmf(v0[1]), v0[2] * sigmf(v0[3])); w.y = f2h_pk(v1[0] * sigmf(v1[1]), v1[2] * sigmf(v1[3]));
                        *(u32x2*)(U + (ro + bj * 64)) = w; } }
            return; }
        if (u.pn < C_ML / BM) { EpiBf16 e; e.O = O; e.ldc = LDP; e(acc, u, wr, wc, fr, fq); return; }
        LAS unsigned* pad = xp + (wr * 4 + wc) * 256;
        const int row0 = u.pm * BM + wr * 64 + fr, d0 = (u.pn - C_ML / BM) * 64 + wc * 8;
#pragma unroll
        for (int ai = 0; ai < 2; ++ai)
#pragma unroll
            for (int m = 0; m < 4; ++m) { const unsigned ro = (unsigned)(row0 + ai * HALF + m * 16) * 8192u + (unsigned)(d0 + fq * 2048);
#pragma unroll
                for (int bj = 0; bj < 2; ++bj) { float rr[2][4];
#pragma unroll
                    for (int n = 0; n < 2; ++n) { float e[4];
#pragma unroll
                        for (int j = 0; j < 4; ++j) e[j] = 1.f + __expf(-fminf(fmaxf(acc[ai][bj][m][n][j], -30.f), 30.f));
                        rr[n][0] = fminf(e[1] * __builtin_amdgcn_rcpf(e[0]), 60000.f); rr[n][1] = fminf(e[2] * __builtin_amdgcn_rcpf(e[1]), 60000.f);
                        rr[n][2] = fminf(e[3] * __builtin_amdgcn_rcpf(e[2]), 60000.f); rr[n][3] = __builtin_amdgcn_rcpf(e[3]); }
#pragma unroll
                    for (int i = 0; i < 4; ++i) pad[(i * 16 + fr) * 4 + fq] = f2h_pk(rr[0][i], rr[1][i]);
                    asm volatile("s_waitcnt lgkmcnt(0)" ::: "memory");
                    const u32x4 w = *(const LAS u32x4*)(pad + (fq * 16 + fr) * 4);
                    asm volatile("s_waitcnt lgkmcnt(0)" ::: "memory");
                    *(u32x4*)(R + (ro + bj * 32)) = w; } }
    }
};
struct EpiPool {
    static constexpr bool PERM = true, MID = false;
    bf16_t* O; const float* scale; const bf16_t* gc;
    __device__ __forceinline__ void operator()(f32x4 (&acc)[2][2][4][2], const Unit& u, int wr, int wc, int fr, int fq) const {
        const int row0 = u.pm * BM + wr * 64 + fr, col0 = u.pn * BM + wc * 32 + 8 * fq;
#pragma unroll
        for (int bj = 0; bj < 2; ++bj) {
            const f32x4 s0 = *(const f32x4*)(scale + col0 + bj * HALF), s1 = *(const f32x4*)(scale + col0 + bj * HALF + 4);
            u32x4 gv[2][4];
#pragma unroll
            for (int ai = 0; ai < 2; ++ai)
#pragma unroll
                for (int m = 0; m < 4; ++m) gv[ai][m] = *(const u32x4*)(gc + ((unsigned)(row0 + ai * HALF + m * 16) * (unsigned)LDP + col0 + bj * HALF));
#pragma unroll
            for (int ai = 0; ai < 2; ++ai)
#pragma unroll
                for (int m = 0; m < 4; ++m) { const unsigned r = (unsigned)(row0 + ai * HALF + m * 16);
                    float gf[8]; UNPACK8(gv[ai][m], gf);
                    const f32x4 v0 = acc[ai][bj][m][0] * s0, v1 = acc[ai][bj][m][1] * s1;
                    u32x4 w;
                    w.x = cvt_pk_bf16(v0[0] * siluf(gf[0]), v0[1] * siluf(gf[1])); w.y = cvt_pk_bf16(v0[2] * siluf(gf[2]), v0[3] * siluf(gf[3]));
                    w.z = cvt_pk_bf16(v1[0] * siluf(gf[4]), v1[1] * siluf(gf[5])); w.w = cvt_pk_bf16(v1[2] * siluf(gf[6]), v1[3] * siluf(gf[7]));
                    *(u32x4*)(O + (r * 4096u + col0 + bj * HALF)) = w; }
            asm volatile("" ::: "memory"); }
    }
};
struct EpiRes {
    static constexpr bool PERM = false, MID = false;
    const float* xin0; const float* xin1; float* xo; const float* modl;
    __device__ __forceinline__ void operator()(f32x4 (&acc)[2][2][4][2], const Unit& u, int wr, int wc, int fr, int fq) const {
        const int row0 = u.pm * BM + wr * 64 + fr, col0 = u.pn * BM + wc * 32 + 4 * fq;
        const int ci = u.pm < 32 ? 0 : 1 + ((u.pm - 32) >> 2);
        const float* gate = modl + ci * 6144 + 4096;
        const float* xin = u.pm < 32 ? xin0 : xin1;
        f32x4 gv[2][2];
#pragma unroll
        for (int bj = 0; bj < 2; ++bj)
#pragma unroll
            for (int n = 0; n < 2; ++n) gv[bj][n] = *(const f32x4*)(gate + col0 + bj * HALF + n * 16);
#pragma unroll
        for (int ai = 0; ai < 2; ++ai) {
            f32x4 xv[4][2][2];
#pragma unroll
            for (int m = 0; m < 4; ++m)
#pragma unroll
                for (int bj = 0; bj < 2; ++bj)
#pragma unroll
                    for (int n = 0; n < 2; ++n) xv[m][bj][n] = *(const f32x4*)(xin + ((unsigned)(row0 + ai * HALF + m * 16) * 2048u + (unsigned)col0 + bj * HALF + n * 16));
#pragma unroll
            for (int m = 0; m < 4; ++m)
#pragma unroll
                for (int bj = 0; bj < 2; ++bj)
#pragma unroll
                    for (int n = 0; n < 2; ++n) *(f32x4*)(xo + ((unsigned)(row0 + ai * HALF + m * 16) * 2048u + (unsigned)col0 + bj * HALF + n * 16)) = xv[m][bj][n] + gv[bj][n] * acc[ai][bj][m][n];
            asm volatile("" ::: "memory"); }
    }
};
struct EpiMerge {
    static constexpr bool PERM = true, MID = true;
    const unsigned short* R; bf16_t* O;
    __device__ __forceinline__ void scale(f32x4 (&acc)[2][2][4][2], const Unit& u, int i, int wr, int wc, int fr, int fq) const {
        const int row0 = u.pm * BM + wr * 64 + fr, col0 = u.pn * BM + wc * 32 + 8 * fq;
        u32x4 av[2][4][2];
#pragma unroll
        for (int ai = 0; ai < 2; ++ai)
#pragma unroll
            for (int m = 0; m < 4; ++m)
#pragma unroll
                for (int bj = 0; bj < 2; ++bj) av[ai][m][bj] = __builtin_nontemporal_load((const u32x4*)(R + ((unsigned)(row0 + ai * HALF + m * 16) * 8192u + (unsigned)(i * 2048 + col0 + bj * HALF))));
#pragma unroll
        for (int ai = 0; ai < 2; ++ai)
#pragma unroll
            for (int m = 0; m < 4; ++m)
#pragma unroll
                for (int bj = 0; bj < 2; ++bj) { const u32x4 v = av[ai][m][bj];
                    acc[ai][bj][m][0][0] *= h2f_lo(v.x); acc[ai][bj][m][0][1] *= h2f_hi(v.x); acc[ai][bj][m][0][2] *= h2f_lo(v.y); acc[ai][bj][m][0][3] *= h2f_hi(v.y);
                    acc[ai][bj][m][1][0] *= h2f_lo(v.z); acc[ai][bj][m][1][1] *= h2f_hi(v.z); acc[ai][bj][m][1][2] *= h2f_lo(v.w); acc[ai][bj][m][1][3] *= h2f_hi(v.w); }
        asm volatile("" ::: "memory");
    }
    __device__ __forceinline__ void mid(f32x4 (&acc)[2][2][4][2], const Unit& u, int tb, int wr, int wc, int fr, int fq) const { scale(acc, u, tb - 1, wr, wc, fr, fq); }
    __device__ __forceinline__ void operator()(f32x4 (&acc)[2][2][4][2], const Unit& u, int wr, int wc, int fr, int fq) const {
        scale(acc, u, 3, wr, wc, fr, fq);
        EpiBf16 e; e.O = O; e.ldc = 2048; e(acc, u, wr, wc, fr, fq);
    }
};
}

__device__ __forceinline__ void conv_jobs(const Params& p, unsigned char* shm, int job_lo, int job_hi, int nb, int bidx) {
    int tid_ = threadIdx.x; asm volatile("" : "+v"(tid_));
    const int tid = tid_, wid = tid >> 6, lane = tid & 63, G = nb;
    unsigned* L = (unsigned*)shm + wid * (64 * 33);
    int ubase = 0;
    for (int job = job_lo; job < job_hi; ++job) {
        const int l = job / 13, jj = job % 13;
        const float* src; int src_ld, dst_ld, N, K, mode = 0; bf16_t* dst;
        if (jj == 0) { src = p.in[8] + (size_t)l * 2048 * INC; src_ld = INC; dst = (bf16_t*)(p.ws + OFF_WIN + l * SZ_WIN1); dst_ld = 2048; N = NIN; K = 2048; mode = 1; }
        else if (jj <= 4) { const int i = jj - 1; src = p.in[21] + (size_t)(l * 4 + i) * 1024 * 2048; src_ld = 2048; dst = (bf16_t*)(p.ws + OFF_WBP + l * SZ_WBP1) + i * 1024; dst_ld = 4096; N = 2048; K = 1024; }
        else if (jj == 5) { src = p.in[22] + (size_t)l * 2048 * 2048; src_ld = 2048; dst = (bf16_t*)(p.ws + OFF_WOUT + l * SZ_WOUT1); dst_ld = 2048; N = 2048; K = 2048; }
        else if (jj == 6) { src = p.in[10] + (size_t)l * 512 * 1536; src_ld = 1536; dst = (bf16_t*)(p.ws + OFF_WQB + l * SZ_WQB1); dst_ld = 512; N = 1536; K = 512; }
        else if (jj == 7) { src = p.in[12] + (size_t)l * 256 * 2048; src_ld = 2048; dst = (bf16_t*)(p.ws + OFF_WK + l * SZ_WK1); dst_ld = 256; N = 1024; K = 256; mode = 2; }
        else if (jj == 8) { src = p.in[12] + (size_t)l * 256 * 2048; src_ld = 2048; dst = (bf16_t*)(p.ws + OFF_WV + l * SZ_WK1); dst_ld = 256; N = 1024; K = 256; mode = 3; }
        else { const int g = jj - 9; src = p.in[15] + (size_t)(l * 4 + g) * 256 * 256; src_ld = 256; dst = (bf16_t*)(p.ws + OFF_WPOOL + l * SZ_WPOOL1) + (size_t)g * 256 * 256; dst_ld = 256; N = 256; K = 256; }
        const int nkt = K >> 6, nunits = ((N >> 6) * nkt) >> 3;
        int first = (bidx - ubase) % G; if (first < 0) first += G;
        for (int u = first; u < nunits; u += G) {
            const int tile = u * 8 + wid, nt = tile / nkt, kt = tile - nt * nkt, n0 = nt * 64, k0 = kt * 64;
            int sc = n0;
            if (mode == 1) sc = n0 < 832 ? n0 : (n0 < 896 ? -1 : (n0 < 8064 ? n0 - 64 : (n0 < C_GLU ? -1 : (n0 < C_GD ? -3 : (n0 < C_ML ? n0 - 192 : -2)))));
            else if (mode == 2) sc = (n0 >> 7) * 256 + (n0 & 127);
            else if (mode == 3) sc = (n0 >> 7) * 256 + 128 + (n0 & 127);
            const int c4 = lane & 15, r = lane >> 4;
            if (sc == -2) {
                const unsigned o0 = (unsigned)(k0 + 2 * r) * (unsigned)src_ld + 11072u + (unsigned)(((n0 - C_ML) >> 2) + c4);
#pragma unroll
                for (int hf = 0; hf < 2; ++hf) {
                    float xa[4][4], xb[4][4];
#pragma unroll
                    for (int i2 = 0; i2 < 4; ++i2)
#pragma unroll
                        for (int j = 0; j < 4; ++j) { const int it = hf * 4 + i2; xa[i2][j] = __builtin_nontemporal_load(src + (o0 + (unsigned)(it * 8) * (unsigned)src_ld + j * 2048u)); xb[i2][j] = __builtin_nontemporal_load(src + (o0 + (unsigned)(it * 8 + 1) * (unsigned)src_ld + j * 2048u)); }
#pragma unroll
                    for (int i2 = 0; i2 < 4; ++i2)
#pragma unroll
                        for (int j = 0; j < 4; ++j) L[(4 * c4 + j) * 33 + (hf * 4 + i2) * 4 + r] = cvt_pk_bf16(xa[i2][j], xb[i2][j]);
                    asm volatile("" ::: "memory"); }
            } else if (sc == -3) {
                const unsigned o0 = (unsigned)(k0 + 2 * r) * (unsigned)src_ld + 8000u + (unsigned)(((n0 - C_GLU) >> 1) + 2 * c4);
#pragma unroll
                for (int hf = 0; hf < 2; ++hf) {
                    float xa[4][4], xb[4][4];
#pragma unroll
                    for (int i2 = 0; i2 < 4; ++i2)
#pragma unroll
                        for (int j = 0; j < 4; ++j) { const int it = hf * 4 + i2; const unsigned oc = (unsigned)((j & 1) * 1024 + (j >> 1));
                            xa[i2][j] = __builtin_nontemporal_load(src + (o0 + (unsigned)(it * 8) * (unsigned)src_ld + oc)); xb[i2][j] = __builtin_nontemporal_load(src + (o0 + (unsigned)(it * 8 + 1) * (unsigned)src_ld + oc)); }
#pragma unroll
                    for (int i2 = 0; i2 < 4; ++i2)
#pragma unroll
                        for (int j = 0; j < 4; ++j) L[(4 * c4 + j) * 33 + (hf * 4 + i2) * 4 + r] = cvt_pk_bf16(xa[i2][j], xb[i2][j]);
                    asm volatile("" ::: "memory"); }
            } else {
            f32x4 va[8], vb[8];
            if (sc >= 0) { const float* sp = src + (size_t)(k0 + 2 * r) * src_ld + sc + 4 * c4;
#pragma unroll
                for (int it = 0; it < 8; ++it) { va[it] = __builtin_nontemporal_load((const f32x4*)(sp + (size_t)(it * 8) * src_ld)); vb[it] = __builtin_nontemporal_load((const f32x4*)(sp + (size_t)(it * 8 + 1) * src_ld)); } }
            else {
#pragma unroll
                for (int it = 0; it < 8; ++it) { va[it] = (f32x4){0.f, 0.f, 0.f, 0.f}; vb[it] = (f32x4){0.f, 0.f, 0.f, 0.f}; } }
#pragma unroll
            for (int it = 0; it < 8; ++it)
#pragma unroll
                for (int j = 0; j < 4; ++j) L[(4 * c4 + j) * 33 + it * 4 + r] = cvt_pk_bf16(va[it][j], vb[it][j]);
            }
            __syncthreads();
#pragma unroll
            for (int ps = 0; ps < 8; ++ps) { const int n = ps * 8 + (lane >> 3), kw = (lane & 7) * 4;
                u32x4 o; o.x = L[n * 33 + kw]; o.y = L[n * 33 + kw + 1]; o.z = L[n * 33 + kw + 2]; o.w = L[n * 33 + kw + 3];
                *(u32x4*)(dst + (size_t)(n0 + n) * dst_ld + k0 + kw * 2) = o; }
            __syncthreads();
        }
        ubase = (ubase + nunits) % G;
    }
}

__device__ __forceinline__ void phase_prep(const Params& p, unsigned char* shm) {
    int tid_ = threadIdx.x; asm volatile("" : "+v"(tid_));
    const int tid = tid_, wid = tid >> 6, lane = tid & 63, G = gridDim.x;
    const float* c = p.in[3]; const float* c_ctx = p.in[4]; const float* w_ada = p.in[5]; const float* b_ada = p.in[6];
    float* mod = (float*)(p.ws + OFF_MOD);
    for (int u = blockIdx.x; u < 192; u += G) {
        const int l = u / 96, cc = u % 96;
        float* s = (float*)shm;
        for (int i = tid; i < 5 * 2048; i += 512) { const int ci = i >> 11, k = i & 2047; const float v = ci == 0 ? c_ctx[k] : c[(ci - 1) * 2048 + k]; s[i] = v / (1.f + expf(-v)); }
        __syncthreads();
        const float* w = w_ada + (size_t)l * 2048 * 6144 + cc * 64 + lane;
        float a0 = 0.f, a1 = 0.f, a2 = 0.f, a3 = 0.f, a4 = 0.f;
        const int kb = wid * 256;
#pragma unroll 32
        for (int k = kb; k < kb + 256; ++k) { const float wv = __builtin_nontemporal_load(w + (size_t)k * 6144); a0 += s[k] * wv; a1 += s[2048 + k] * wv; a2 += s[4096 + k] * wv; a3 += s[6144 + k] * wv; a4 += s[8192 + k] * wv; }
        float* red = (float*)(shm + 40960);
        red[(wid * 5 + 0) * 64 + lane] = a0; red[(wid * 5 + 1) * 64 + lane] = a1; red[(wid * 5 + 2) * 64 + lane] = a2; red[(wid * 5 + 3) * 64 + lane] = a3; red[(wid * 5 + 4) * 64 + lane] = a4;
        __syncthreads();
        if (tid < 320) { const int ci = tid >> 6; float r = 0.f;
#pragma unroll
            for (int w8 = 0; w8 < 8; ++w8) r += red[(w8 * 5 + ci) * 64 + lane];
            const int col = cc * 64 + lane; mod[(size_t)(l * 5 + ci) * 6144 + col] = r + b_ada[l * 6144 + col]; }
        __syncthreads();
    }
    conv_jobs(p, shm, 0, 13, G, blockIdx.x);
}

__device__ __forceinline__ void phase_norm(const Params& p, int l, int r_lo, int r_hi, int nb, int bidx) {
    int tid_ = threadIdx.x; asm volatile("" : "+v"(tid_));
    const int tid = tid_, wid = tid >> 6, lane = tid & 63, G = gridDim.x;
    const float* nw = p.in[7] + l * 2048;
    const float* mod = (const float*)(p.ws + OFF_MOD);
    const float* xres = (const float*)(p.ws + OFF_XRES);
    bf16_t* h = (bf16_t*)(p.ws + OFF_H);
    for (int r = r_lo + bidx * 8 + wid; r < r_hi; r += nb * 8) {
        const float* x = l == 0 ? (r < TC ? p.in[0] + (size_t)r * 2048 : p.in[1] + (size_t)(r - TC) * 2048) : xres + (size_t)r * 2048;
        const int ci = r < TC ? 0 : 1 + ((r - TC) >> 10);
        const float* md = mod + (size_t)(l * 5 + ci) * 6144;
        f32x4 v[8]; float ss = 0.f;
#pragma unroll
        for (int j = 0; j < 8; ++j) { v[j] = *(const f32x4*)(x + j * 256 + lane * 4); ss += v[j][0] * v[j][0] + v[j][1] * v[j][1] + v[j][2] * v[j][2] + v[j][3] * v[j][3]; }
        ss = wave_sum(ss, lane);
        const float rstd = 1.f / sqrtf(ss * (1.f / 2048.f) + EPS);
#pragma unroll
        for (int j = 0; j < 8; ++j) { const int cix = j * 256 + lane * 4;
            const f32x4 w4 = *(const f32x4*)(nw + cix), sh = *(const f32x4*)(md + cix), sc = *(const f32x4*)(md + 2048 + cix);
            const f32x4 y = v[j] * rstd * w4 * (sc + 1.f) + sh;
            u32x2 o; o.x = cvt_pk_bf16(y[0], y[1]); o.y = cvt_pk_bf16(y[2], y[3]);
            *(u32x2*)(h + (size_t)r * 2048 + cix) = o; }
    }
}

__device__ __forceinline__ void phase_final(const Params& p, int r_lo, int r_hi, int nb, int bidx) {
    int tid_ = threadIdx.x; asm volatile("" : "+v"(tid_));
    const int tid = tid_, wid = tid >> 6, lane = tid & 63, G = gridDim.x;
    const float* fw = p.in[23];
    const float* xres = (const float*)(p.ws + OFF_XRES);
    for (int r = r_lo + bidx * 8 + wid; r < r_hi; r += nb * 8) {
        const float* x = xres + (size_t)r * 2048;
        f32x4 v[8]; float ss = 0.f;
#pragma unroll
        for (int j = 0; j < 8; ++j) { v[j] = *(const f32x4*)(x + j * 256 + lane * 4); ss += v[j][0] * v[j][0] + v[j][1] * v[j][1] + v[j][2] * v[j][2] + v[j][3] * v[j][3]; }
        ss = wave_sum(ss, lane);
        const float rstd = 1.f / sqrtf(ss * (1.f / 2048.f) + EPS);
#pragma unroll
        for (int j = 0; j < 8; ++j) { const int cix = j * 256 + lane * 4; const f32x4 w4 = *(const f32x4*)(fw + cix);
            *(f32x4*)(p.out + (size_t)r * 2048 + cix) = v[j] * rstd * w4; }
    }
}

__device__ __forceinline__ void phase_elem(const Params& p, int l, unsigned char* shm) {
    int tid_ = threadIdx.x; asm volatile("" : "+v"(tid_));
    const int tid = tid_, wid = tid >> 6, lane = tid & 63, G = gridDim.x;
    const bf16_t* proj = (const bf16_t*)(p.ws + OFF_PROJ);
    bf16_t* qn = (bf16_t*)(p.ws + OFF_QN);
    bf16_t* kvall = (bf16_t*)(p.ws + OFF_KVALL);
    bf16_t* pooled = (bf16_t*)(p.ws + OFF_POOLED);
    bf16_t* ycat = (bf16_t*)(p.ws + OFF_YCAT);
    float* outc = p.out + (size_t)T * 2048;
    const bf16_t* ug = (const bf16_t*)(p.ws + OFF_U);
    { const float* cache = p.in[2];
      for (int i = blockIdx.x * 512 + tid; i < 4 * 256 * 320; i += G * 512) { const int j = i / (256 * 320), rem = i % (256 * 320), s = rem / 320, cc = rem % 320;
          const float v = cache[((size_t)(j * 2 + l) * 256 + s) * 320 + cc]; kvall[(size_t)(TC + j * 1280 + s) * 320 + cc] = (bf16_t)(cvt_pk_bf16(v, 0.f) & 0xffffu); } }
    const float* qnw = p.in[9] + l * 512; const float* kvnw = p.in[11] + l * 256;
    const float* c3w = p.in[13] + l * 3 * 1024; const float* c3b = p.in[14] + l * 1024;
    const float* dww = p.in[17] + l * 31 * 1024; const float* dwb = p.in[18] + l * 1024;
    const float* clw = p.in[19] + l * 1024; const float* clb = p.in[20] + l * 1024;
    for (int tile = blockIdx.x; tile < 768; tile += G) {
        const int t0 = tile * 16; const bool lat = t0 >= TC;
        const int s0 = lat ? TC + ((t0 - TC) & ~1023) : (t0 & ~255), s1 = s0 + (lat ? 1024 : 256);
#pragma unroll
        for (int i = 0; i < 2; ++i) {
            const int t = t0 + wid * 2 + i; const bf16_t* pr = proj + (size_t)t * LDP;
            { const u32x4 qv = *(const u32x4*)(pr + lane * 8); float f[8]; UNPACK8(qv, f);
              float ss = 0.f;
#pragma unroll
              for (int e = 0; e < 8; ++e) ss += f[e] * f[e];
              ss = wave_sum(ss, lane); const float rstd = 1.f / sqrtf(ss * (1.f / 512.f) + EPS);
              const f32x4 wa = *(const f32x4*)(qnw + lane * 8), wb = *(const f32x4*)(qnw + lane * 8 + 4);
              float o[8];
#pragma unroll
              for (int e = 0; e < 4; ++e) { o[e] = f[e] * rstd * wa[e]; o[4 + e] = f[4 + e] * rstd * wb[e]; }
              u32x4 w; PACK8(o, w); *(u32x4*)(qn + (size_t)t * 512 + lane * 8) = w; }
            { u32x4 kv = (u32x4){0u, 0u, 0u, 0u}; if (lane < 40) kv = *(const u32x4*)(pr + C_KVA + lane * 8);
              float g[8]; UNPACK8(kv, g);
              float ss = 0.f;
              if (lane < 32) {
#pragma unroll
                  for (int e = 0; e < 8; ++e) ss += g[e] * g[e]; }
              ss = wave_sum(ss, lane); const float rstd = 1.f / sqrtf(ss * (1.f / 256.f) + EPS);
              float pv[8];
#pragma unroll
              for (int e = 0; e < 8; ++e) pv[e] = swz_xor<2>(g[e]);
              float o[8];
              if (lane < 32) { const f32x4 wa = *(const f32x4*)(kvnw + lane * 8), wb = *(const f32x4*)(kvnw + lane * 8 + 4);
#pragma unroll
                  for (int e = 0; e < 4; ++e) { o[e] = g[e] * rstd * wa[e]; o[4 + e] = g[4 + e] * rstd * wb[e]; } }
              else if (lat && lane < 40) { const int q = lane - 32, tl = t - s0, axis = q >> 2, ib = (q & 1) * 8; const bool second = (q & 2) != 0;
                  const float pos = (float)(axis ? (tl & 63) : (tl >> 6));
#pragma unroll
                  for (int e = 0; e < 8; ++e) { const float ang = pos * rope_inv(ib + e); const float sn = __sinf(ang), cs = __cosf(ang);
                      o[e] = second ? g[e] * cs + pv[e] * sn : g[e] * cs - pv[e] * sn; } }
              else {
#pragma unroll
                  for (int e = 0; e < 8; ++e) o[e] = g[e]; }
              if (lane < 40) {
                  const int row = lat ? TC + ((t - TC) >> 10) * 1280 + 256 + (t - s0) : t;
                  u32x4 w; PACK8(o, w); *(u32x4*)(kvall + (size_t)row * 320 + lane * 8) = w;
                  if (!lat) { const int b = t >> 8, s = t & 255; float* oc = outc + ((size_t)(b * 2 + l) * 256 + s) * 320 + lane * 8;
                      *(f32x4*)oc = (f32x4){o[0], o[1], o[2], o[3]}; *(f32x4*)(oc + 4) = (f32x4){o[4], o[5], o[6], o[7]}; } } }
        }
        { const int cg8 = tid & 127, rsub = tid >> 7, c0 = cg8 * 8;
          float w0[8], w1[8], w2[8], bb[8];
#pragma unroll
          for (int e = 0; e < 8; ++e) { w0[e] = c3w[c0 + e]; w1[e] = c3w[1024 + c0 + e]; w2[e] = c3w[2048 + c0 + e]; bb[e] = c3b[c0 + e]; }
          const int grp = cg8 >> 5, win = 2 << grp;
#pragma unroll
          for (int ps = 0; ps < 8; ++ps) { const int rr = ps * 4 + rsub, t = t0 - 8 + rr; u32x4 o = (u32x4){0u, 0u, 0u, 0u};
              if (t >= s0 && t < s1) o = *(const u32x4*)(proj + (size_t)t * LDP + C_XP + c0);
              *(u32x4*)(shm + rr * 2048 + c0 * 2) = o; }
          __syncthreads();
#pragma unroll
          for (int ps = 0; ps < 4; ++ps) {
              const int t = t0 + ps * 4 + rsub; const bf16_t* pr = proj + (size_t)t * LDP;
              float pm[8], p0[8], pp[8];
              { const u32x4 a = *(const u32x4*)(pr + C_CG + c0), b = *(const u32x4*)(pr + C_XC + c0); float fa[8], fb[8]; UNPACK8(a, fa); UNPACK8(b, fb);
#pragma unroll
                for (int e = 0; e < 8; ++e) p0[e] = fa[e] * fb[e]; }
              if (t - 1 >= s0) { const u32x4 a = *(const u32x4*)(pr - LDP + C_CG + c0), b = *(const u32x4*)(pr - LDP + C_XC + c0); float fa[8], fb[8]; UNPACK8(a, fa); UNPACK8(b, fb);
#pragma unroll
                for (int e = 0; e < 8; ++e) pm[e] = fa[e] * fb[e]; }
              else {
#pragma unroll
                for (int e = 0; e < 8; ++e) pm[e] = 0.f; }
              if (t + 1 < s1) { const u32x4 a = *(const u32x4*)(pr + LDP + C_CG + c0), b = *(const u32x4*)(pr + LDP + C_XC + c0); float fa[8], fb[8]; UNPACK8(a, fa); UNPACK8(b, fb);
#pragma unroll
                for (int e = 0; e < 8; ++e) pp[e] = fa[e] * fb[e]; }
              else {
#pragma unroll
                for (int e = 0; e < 8; ++e) pp[e] = 0.f; }
              { const u32x4 a = *(const u32x4*)(pr + C_BG + c0), b = *(const u32x4*)(pr + C_GB + c0); float fa[8], fb[8]; UNPACK8(a, fa); UNPACK8(b, fb);
                float o[8];
#pragma unroll
                for (int e = 0; e < 8; ++e) o[e] = fa[e] * (w0[e] * pm[e] + w1[e] * p0[e] + w2[e] * pp[e] + bb[e]) * siluf(fb[e]);
                u32x4 w; PACK8(o, w); *(u32x4*)(ycat + (size_t)t * 4096 + 1024 + c0) = w; }
              { int lo = t - (win >> 1), hi = lo + win; const int lrow = t - t0 + 8 - (win >> 1); lo = lo < s0 ? s0 : lo; hi = hi > s1 ? s1 : hi;
                float sm[8];
#pragma unroll
                for (int e = 0; e < 8; ++e) sm[e] = 0.f;
#pragma unroll 4
                for (int j = 0; j < win; ++j) { const u32x4 a = *(const u32x4*)(shm + (lrow + j) * 2048 + c0 * 2); float fa[8]; UNPACK8(a, fa);
#pragma unroll
                    for (int e = 0; e < 8; ++e) sm[e] += fa[e]; }
                const u32x4 a = *(const u32x4*)(shm + (t - t0 + 8) * 2048 + c0 * 2); float fa[8]; UNPACK8(a, fa);
                const float inv = 1.f / (float)(hi - lo);
                float o[8];
#pragma unroll
                for (int e = 0; e < 8; ++e) o[e] = sm[e] * inv - fa[e];
                u32x4 w; PACK8(o, w); *(u32x4*)(pooled + (size_t)t * 1024 + c0) = w; }
          }
          __syncthreads(); }
        { const int cg8 = tid & 127, rsub = tid >> 7, c0 = cg8 * 8;
#pragma unroll
          for (int ps = 0; ps < 12; ++ps) { const int rr = ps * 4 + rsub;
              if (rr < 46) { const int t = t0 - 15 + rr; u32x4 o = (u32x4){0u, 0u, 0u, 0u};
                  if (t >= s0 && t < s1) o = *(const u32x4*)(ug + (size_t)t * 1024 + c0);
                  *(u32x4*)(shm + rr * 2048 + c0 * 2) = o; } }
          __syncthreads();
          const unsigned* ut = (const unsigned*)shm + tid;
          const f32x2 bv = *(const f32x2*)(dwb + 2 * tid);
          f32x2* red = (f32x2*)(shm + 126976);
          f32x2* stat = (f32x2*)(shm + 129024);
          float a0[16], a1[16];
#pragma unroll
          for (int t = 0; t < 16; ++t) { a0[t] = bv.x; a1[t] = bv.y; }
          f32x2 wc[4];
#pragma unroll
          for (int j = 0; j < 4; ++j) wc[j] = *(const f32x2*)(dww + j * 1024 + 2 * tid);
#pragma unroll 1
          for (int kg = 0; kg < 8; ++kg) {
              f32x2 wn[4];
#pragma unroll
              for (int j = 0; j < 4; ++j) { const int kn = kg * 4 + 4 + j; wn[j] = *(const f32x2*)(dww + (kn < 31 ? kn : 30) * 1024 + 2 * tid); }
#pragma unroll
              for (int j = 0; j < 4; ++j) { const int k = kg * 4 + j;
                  if (k < 31) { const unsigned* xr = ut + k * 512;
#pragma unroll
                      for (int t = 0; t < 16; ++t) { const unsigned uu = xr[t * 512]; fma_mix_lo(a0[t], wc[j].x, uu); fma_mix_hi(a1[t], wc[j].y, uu); } } }
#pragma unroll
              for (int j = 0; j < 4; ++j) wc[j] = wn[j];
          }
#pragma unroll
          for (int t = 0; t < 16; ++t) { float a = a0[t] + a1[t], b = a0[t] * a0[t] + a1[t] * a1[t]; a = wave_sum(a, lane); b = wave_sum(b, lane);
              if (lane == 0) red[t * 8 + wid] = (f32x2){a, b}; }
          __syncthreads();
          if (tid < 16) { float a = 0.f, b = 0.f;
#pragma unroll
              for (int w8 = 0; w8 < 8; ++w8) { const f32x2 r = red[tid * 8 + w8]; a += r.x; b += r.y; }
              const float mu = a * (1.f / 1024.f), var = fmaxf(b * (1.f / 1024.f) - mu * mu, 0.f); stat[tid] = (f32x2){mu, 1.f / sqrtf(var + EPS)}; }
          __syncthreads();
          const f32x2 cw = *(const f32x2*)(clw + 2 * tid), cb = *(const f32x2*)(clb + 2 * tid);
#pragma unroll
          for (int t = 0; t < 16; ++t) { const f32x2 st = stat[t];
              const unsigned gd = *(const unsigned*)(proj + ((unsigned)(t0 + t) * (unsigned)LDP + C_GD + 2 * tid));
              const float y0 = siluf((a0[t] - st.x) * st.y * cw.x + cb.x) * siluf(bf_lo(gd)), y1 = siluf((a1[t] - st.x) * st.y * cw.y + cb.y) * siluf(bf_hi(gd));
              *(unsigned*)(ycat + ((unsigned)(t0 + t) * 4096u + 3072 + 2 * tid)) = cvt_pk_bf16(y0, y1); }
          __syncthreads(); }
    }
}

__device__ __forceinline__ void phase_attn(const Params& p, int l, unsigned char* shm) {
    int tid_ = threadIdx.x; asm volatile("" : "+v"(tid_));
    const int tid = tid_, wid = tid >> 6, lane = tid & 63, G = gridDim.x, qr = lane & 15, kq = lane >> 4;
    const bf16_t* proj = (const bf16_t*)(p.ws + OFF_PROJ);
    const bf16_t* qb = (const bf16_t*)(p.ws + OFF_Q);
    const bf16_t* kvall = (const bf16_t*)(p.ws + OFF_KVALL);
    const bf16_t* knope = (const bf16_t*)(p.ws + OFF_KNOPE);
    const bf16_t* vt = (const bf16_t*)(p.ws + OFF_VT);
    bf16_t* ycat = (bf16_t*)(p.ws + OFF_YCAT);
    bf16_t* Qs = (bf16_t*)shm;
    bf16_t* Ks = (bf16_t*)(shm + 51200);
    bf16_t* Vs = (bf16_t*)(shm + 76800);
    const float cscale = 0.07216878364870322f * 1.4426950408889634f;
    for (int u = blockIdx.x; u < 768; u += G) {
        int h, tq, kr0, Lk, tl0; bool rope;
        if (u < 256) { const int j = u >> 6; h = (u >> 3) & 7; const int qblk = u & 7; tq = TC + j * 1024 + qblk * 128; kr0 = TC + j * 1280; Lk = 1280; rope = true; tl0 = qblk * 128; }
        else { const int v = u - 256, b = v >> 4; h = (v >> 1) & 7; const int qblk = v & 1; tq = b * 256 + qblk * 128; kr0 = b * 256; Lk = 256; rope = false; tl0 = 0; }
        __syncthreads();
#pragma unroll
        for (int ps = 0; ps < 4; ++ps) { const int id = ps * 512 + tid, r = id >> 4, c8 = id & 15;
            const u32x4 v = *(const u32x4*)(qb + (size_t)(tq + r) * 1536 + h * 192 + c8 * 8); *(u32x4*)(Qs + r * 200 + c8 * 8) = v; }
        { const int r = tid >> 2, axis = (tid >> 1) & 1, ig = tid & 1; const bf16_t* src = qb + (size_t)(tq + r) * 1536 + h * 192 + 128 + axis * 32 + ig * 8;
          u32x4 a = *(const u32x4*)src, b = *(const u32x4*)(src + 16);
          if (rope) { float x1[8], x2[8], y1[8], y2[8]; UNPACK8(a, x1); UNPACK8(b, x2); const int tl = tl0 + r; const float pos = (float)(axis ? (tl & 63) : (tl >> 6));
#pragma unroll
              for (int e = 0; e < 8; ++e) { const float ang = pos * rope_inv(ig * 8 + e); const float sn = __sinf(ang), cs = __cosf(ang); y1[e] = x1[e] * cs - x2[e] * sn; y2[e] = x2[e] * cs + x1[e] * sn; }
              PACK8(y1, a); PACK8(y2, b); }
          bf16_t* d = Qs + r * 200 + 128 + axis * 32 + ig * 8; *(u32x4*)d = a; *(u32x4*)(d + 16) = b; }
        bf16x8 qf[6];
        f32x4 o[8];
#pragma unroll
        for (int nb = 0; nb < 8; ++nb) o[nb] = (f32x4){0.f, 0.f, 0.f, 0.f};
        float m = -INFINITY, lsum = 0.f;
        u32x4 kreg[3], vreg[2];
#define ATT_LOAD(kc) do { \
            _Pragma("unroll") for (int ps = 0; ps < 3; ++ps) { const int id = ps * 512 + tid, r = id / 24, cc = id - r * 24; \
                const bf16_t* src = cc < 16 ? knope + (size_t)(kr0 + (kc) + r) * 1024 + h * 128 + cc * 8 : kvall + (size_t)(kr0 + (kc) + r) * 320 + 256 + (cc - 16) * 8; \
                kreg[ps] = *(const u32x4*)src; } \
            _Pragma("unroll") for (int ps = 0; ps < 2; ++ps) { const int id = ps * 512 + tid, d = id >> 3, c8 = id & 7; \
                vreg[ps] = *(const u32x4*)(vt + (size_t)(h * 128 + d) * KVR + kr0 + (kc) + c8 * 8); } } while (0)
#define ATT_STORE(Kb, Vb) do { \
            _Pragma("unroll") for (int ps = 0; ps < 3; ++ps) { const int id = ps * 512 + tid, r = id / 24, cc = id - r * 24; *(u32x4*)((Kb) + r * 200 + cc * 8) = kreg[ps]; } \
            _Pragma("unroll") for (int ps = 0; ps < 2; ++ps) { const int id = ps * 512 + tid, d = id >> 3, c8 = id & 7; *(u32x4*)((Vb) + d * 72 + c8 * 8) = vreg[ps]; } } while (0)
        bf16_t* const Ks1 = (bf16_t*)shm; bf16_t* const Vs1 = (bf16_t*)(shm + 25600);
        ATT_LOAD(0);
        ATT_STORE(Ks, Vs);
        __syncthreads();
#pragma unroll
        for (int c = 0; c < 6; ++c) qf[c] = *(const bf16x8*)(Qs + (wid * 16 + qr) * 200 + c * 32 + kq * 8);
        if (64 < Lk) ATT_LOAD(64);
        __syncthreads();
        for (int k0 = 0; k0 < Lk; k0 += 64) {
            const bool odd = (k0 & 64) != 0;
            const bf16_t* Kc = odd ? Ks1 : Ks; const bf16_t* Vc = odd ? Vs1 : Vs;
            if (k0 + 64 < Lk) { if (odd) ATT_STORE(Ks, Vs); else ATT_STORE(Ks1, Vs1); }
            if (k0 + 128 < Lk) ATT_LOAD(k0 + 128);
            f32x4 s[4];
#pragma unroll
            for (int kb = 0; kb < 4; ++kb) { s[kb] = (f32x4){0.f, 0.f, 0.f, 0.f};
#pragma unroll
                for (int c = 0; c < 6; ++c) { const bf16x8 kf = *(const bf16x8*)(Kc + (kb * 16 + qr) * 200 + c * 32 + kq * 8); s[kb] = __builtin_amdgcn_mfma_f32_16x16x32_bf16(kf, qf[c], s[kb], 0, 0, 0); } }
            float mx = s[0][0];
#pragma unroll
            for (int kb = 0; kb < 4; ++kb)
#pragma unroll
                for (int j = 0; j < 4; ++j) mx = fmaxf(mx, s[kb][j]);
            mx = fmaxf(mx, swz_xor<16>(mx)); mx = fmaxf(mx, bperm_xor32(mx, lane));
            const float mn = fmaxf(m, mx), alpha = __builtin_amdgcn_exp2f((m - mn) * cscale); m = mn;
            float psum = 0.f;
#pragma unroll
            for (int kb = 0; kb < 4; ++kb)
#pragma unroll
                for (int j = 0; j < 4; ++j) { const float e = __builtin_amdgcn_exp2f((s[kb][j] - mn) * cscale); s[kb][j] = e; psum += e; }
            lsum = lsum * alpha + psum;
#pragma unroll
            for (int nb = 0; nb < 8; ++nb) o[nb] *= alpha;
#pragma unroll
            for (int hb = 0; hb < 2; ++hb) {
                u32x4 pw; pw.x = cvt_pk_bf16(s[2 * hb][0], s[2 * hb][1]); pw.y = cvt_pk_bf16(s[2 * hb][2], s[2 * hb][3]); pw.z = cvt_pk_bf16(s[2 * hb + 1][0], s[2 * hb + 1][1]); pw.w = cvt_pk_bf16(s[2 * hb + 1][2], s[2 * hb + 1][3]);
                const bf16x8 pf = __builtin_bit_cast(bf16x8, pw);
#pragma unroll
                for (int nb = 0; nb < 8; ++nb) { const bf16_t* vp = Vc + (nb * 16 + qr) * 72 + hb * 32 + kq * 4;
                    const u32x2 lo = *(const u32x2*)vp, hi = *(const u32x2*)(vp + 16);
                    const u32x4 vw = (u32x4){lo.x, lo.y, hi.x, hi.y};
                    o[nb] = __builtin_amdgcn_mfma_f32_16x16x32_bf16(__builtin_bit_cast(bf16x8, vw), pf, o[nb], 0, 0, 0); } }
            __syncthreads();
        }
        float lt = lsum + swz_xor<16>(lsum); lt += bperm_xor32(lt, lane);
        const float inv = 1.f / lt;
        const int token = tq + wid * 16 + qr;
#pragma unroll
        for (int nb = 0; nb < 8; ++nb) { const int dv0 = nb * 16 + kq * 4;
            const u32x2 ga = *(const u32x2*)(proj + (size_t)token * LDP + C_GA + h * 128 + dv0);
            const float y0 = o[nb][0] * inv * siluf(bf_lo(ga.x)), y1 = o[nb][1] * inv * siluf(bf_hi(ga.x)), y2 = o[nb][2] * inv * siluf(bf_lo(ga.y)), y3 = o[nb][3] * inv * siluf(bf_hi(ga.y));
            u32x2 w; w.x = cvt_pk_bf16(y0, y1); w.y = cvt_pk_bf16(y2, y3);
            *(u32x2*)(ycat + (size_t)token * 4096 + h * 128 + dv0) = w; }
    }
}

#define XB_TMO      128
#define XB_XCNT(j)  (256  + 64 * (j))
#define XB_XSUB(j)  (1280 + 64 * (j))
#define XB_XGEN(j)  (2304 + 64 * (j))
#define XB_TOP      3328
#define XB_TOPGEN   3392
#define XB_SPIN_CAP (1u << 22)
__device__ __forceinline__ unsigned xb_ld(unsigned* p)              { return __hip_atomic_load(p, __ATOMIC_RELAXED, __HIP_MEMORY_SCOPE_AGENT); }
__device__ __forceinline__ unsigned xb_add(unsigned* p, unsigned v) { return __hip_atomic_fetch_add(p, v, __ATOMIC_RELAXED, __HIP_MEMORY_SCOPE_AGENT); }
__device__ __forceinline__ unsigned xb_xcc_id() { return (unsigned)__builtin_amdgcn_s_getreg((3 << 11) | 20) & 0xFu; }
#define XB_SPIN(cond, bar) do { unsigned _sp = 0; while (cond) { __builtin_amdgcn_s_sleep(1); \
    if ((++_sp & 255u) == 0u) { if (xb_ld(&(bar)[XB_TMO])) break; if (_sp > XB_SPIN_CAP) { atomicAdd(&(bar)[XB_TMO], 1u); break; } } } } while (0)
__device__ __forceinline__ void xcd_barrier_complete(unsigned* bar, unsigned x, unsigned& nloc, unsigned& nx) {
    const unsigned G = gridDim.x * gridDim.y * gridDim.z;
    unsigned sum, cnt, mine, sp = 0u;
    for (;;) {
        sum = 0u; cnt = 0u; mine = 0u;
#pragma unroll
        for (unsigned j = 0; j < 16; ++j) { const unsigned c = xb_ld(&bar[XB_XCNT(j)]); sum += c; cnt += (c > 0u) ? 1u : 0u; mine = (j == x) ? c : mine; }
        if (sum == G) break;
        __builtin_amdgcn_s_sleep(1);
        if ((++sp & 255u) == 0u) { if (xb_ld(&bar[XB_TMO])) break; if (sp > XB_SPIN_CAP) { atomicAdd(&bar[XB_TMO], 1u); break; } }
    }
    nloc = mine > 0u ? mine : 1u; nx = cnt > 0u ? cnt : 1u;
}
__device__ __forceinline__ void xcd_barrier(unsigned* bar, volatile LAS unsigned* st) {
    asm volatile("s_waitcnt vmcnt(0)" ::: "memory");
    __syncthreads();
    if (threadIdx.x == 0) {
        const unsigned x = xb_xcc_id();
        __builtin_amdgcn_s_waitcnt(0);
        unsigned nloc = st[0], nx = st[1];
        if (nloc == 0u) { xcd_barrier_complete(bar, x, nloc, nx); st[0] = nloc; st[1] = nx; }
        const unsigned old = xb_add(&bar[XB_XSUB(x)], 1u);
        const unsigned gen = old / nloc;
        if (old + 1u == (gen + 1u) * nloc) {
            __builtin_amdgcn_fence(__ATOMIC_RELEASE, "agent");
            asm volatile("s_waitcnt vmcnt(0)" ::: "memory");
            const unsigned og = xb_add(&bar[XB_TOP], 1u);
            const unsigned tg = og / nx;
            if (og + 1u == (tg + 1u) * nx) xb_add(&bar[XB_TOPGEN], 1u);
            else XB_SPIN(xb_ld(&bar[XB_TOPGEN]) == tg, bar);
            __builtin_amdgcn_fence(__ATOMIC_ACQUIRE, "agent");
            xb_add(&bar[XB_XGEN(x)], 1u);
            asm volatile("s_waitcnt vmcnt(0)" ::: "memory");
        } else {
            XB_SPIN(xb_ld(&bar[XB_XGEN(x)]) == gen, bar);
            __builtin_amdgcn_fence(__ATOMIC_ACQUIRE, "agent");
            asm volatile("s_waitcnt vmcnt(0)" ::: "memory");
        }
    }
    __syncthreads();
}

#define LAUNDER() \
        int z_ = 0; asm volatile("" : "+s"(z_)); \
        const __attribute__((address_space(4))) unsigned char* kp_ = (const __attribute__((address_space(4))) unsigned char*)__builtin_amdgcn_kernarg_segment_ptr(); \
        asm volatile("" : "+s"(kp_)); \
        const Params& p = *(const Params*)kp_; \
        LAS unsigned char* lds = lds0 + z_; \
        unsigned char* shm = (unsigned char*)lds; (void)shm; (void)lds; (void)p;
#define RUNPH(idx, ...) do { const int idx_ = (idx); if (idx_ >= ph_lo && idx_ < ph_hi) { { LAUNDER() __VA_ARGS__ } if (idx_ + 1 < ph_hi) { LAUNDER() xcd_barrier((unsigned*)(p.ws + OFF_BAR), (volatile LAS unsigned*)(lds0 + 131072)); } } } while (0)

template <int l> __device__ __forceinline__ void run_layer(cg::grid_group& grid, LAS unsigned char* lds0, int ph_lo, int ph_hi) {
        constexpr int pb = 1 + 8 * l;

        RUNPH(pb + 0, { if (l == 0) phase_norm(p, 0, 0, T, (int)gridDim.x, (int)blockIdx.x); else phase_norm(p, l, TC, T, (int)gridDim.x, (int)blockIdx.x); });
        RUNPH(pb + 1, {
            const int G = gridDim.x, bid = blockIdx.x;
            pg8::Gemm g; pg8::EpiWin e;
            g.A = (const bf16_t*)(p.ws + OFF_H); g.lda = 2048; g.Bt = (const bf16_t*)(p.ws + OFF_WIN + l * SZ_WIN1); g.ldb = 2048; g.M = T; g.N = NIN; g.K = 2048; e.O = (bf16_t*)(p.ws + OFF_PROJ); e.R = (unsigned short*)(p.ws + OFF_RAT); e.U = (bf16_t*)(p.ws + OFF_U); e.xp = (LAS unsigned*)(lds + LDS_XP);
            pg8::StaticOrder S; S.init(g.M, g.N, G, bid);
            pg8::gemm_phase<pg8::EpiWin>(lds, g, S, e);
            if (l == 0) { const int extra = S.nwg % G;
                if (extra > 0) { if (bid >= extra) conv_jobs(p, shm, 13, 26, G - extra, bid - extra); }
                else conv_jobs(p, shm, 13, 26, G, bid); } });
        RUNPH(pb + 2, phase_elem(p, l, shm););
        RUNPH(pb + 3, {
            const int G = gridDim.x, bid = blockIdx.x;
            int start = 0;
            { pg8::Gemm g; pg8::EpiBf16 e;
              g.A = (const bf16_t*)(p.ws + OFF_QN); g.lda = 512; g.Bt = (const bf16_t*)(p.ws + OFF_WQB + l * SZ_WQB1); g.ldb = 512; g.M = T; g.N = 1536; g.K = 512; e.O = (bf16_t*)(p.ws + OFF_Q); e.ldc = 1536;
              pg8::StaticOrder S; S.init(g.M, g.N, G, bid);
              pg8::gemm_phase<pg8::EpiBf16>(lds, g, S, e); start += S.nwg; }
            { LAUNDER()
              pg8::Gemm g; pg8::EpiBf16 e;
              g.A = (const bf16_t*)(p.ws + OFF_KVALL); g.lda = 320; g.Bt = (const bf16_t*)(p.ws + OFF_WK + l * SZ_WK1); g.ldb = 256; g.M = KVR; g.N = 1024; g.K = 256; e.O = (bf16_t*)(p.ws + OFF_KNOPE); e.ldc = 1024;
              pg8::StaticOrder S; S.init(g.M, g.N, G, (bid - start % G + G) % G);
              pg8::gemm_phase<pg8::EpiBf16>(lds, g, S, e); start += S.nwg; }
            { LAUNDER()
              pg8::Gemm g; pg8::EpiBf16 e;
              g.A = (const bf16_t*)(p.ws + OFF_WV + l * SZ_WK1); g.lda = 256; g.Bt = (const bf16_t*)(p.ws + OFF_KVALL); g.ldb = 320; g.M = 1024; g.N = KVR; g.K = 256; e.O = (bf16_t*)(p.ws + OFF_VT); e.ldc = KVR;
              pg8::StaticOrder S; S.init(g.M, g.N, G, (bid - start % G + G) % G);
              pg8::gemm_phase<pg8::EpiBf16>(lds, g, S, e); start += S.nwg; }
            { LAUNDER()
              const int G2 = gridDim.x;
              pg8::Gemm g; g.A = (const bf16_t*)(p.ws + OFF_POOLED); g.lda = 1024; g.a_pn = 256; g.Bt = (const bf16_t*)(p.ws + OFF_WPOOL + l * SZ_WPOOL1); g.ldb = 256; g.M = T; g.N = 1024; g.K = 256;
              pg8::EpiPool e; e.O = (bf16_t*)(p.ws + OFF_YCAT) + 2048; e.scale = p.in[16] + l * 1024; e.gc = (const bf16_t*)(p.ws + OFF_PROJ) + C_GC;
              pg8::StaticOrder S; S.init(g.M, g.N, G2, ((int)blockIdx.x + G2 - start % G2) % G2);
              pg8::gemm_phase<pg8::EpiPool>(lds, g, S, e); } });
        RUNPH(pb + 4, phase_attn(p, l, shm););
#define MK_MERGE_GEMM(Mrows, Gx, cx, pmo) do { \
            pg8::Gemm g; g.A = (const bf16_t*)(p.ws + OFF_YCAT); g.lda = 4096; g.Bt = (const bf16_t*)(p.ws + OFF_WBP + l * SZ_WBP1); g.ldb = 4096; g.M = (Mrows); g.N = 2048; g.K = 4096; \
            pg8::EpiMerge e; e.R = (const unsigned short*)(p.ws + OFF_RAT); e.O = (bf16_t*)(p.ws + OFF_MERGED); \
            pg8::StaticOrder S; S.init(g.M, g.N, (Gx), (cx), (pmo)); \
            pg8::gemm_phase<pg8::EpiMerge>(lds, g, S, e); } while (0)
#define MK_OUT_GEMM(Mrows, Gx, cx, pmo) do { \
            pg8::Gemm g; g.A = (const bf16_t*)(p.ws + OFF_MERGED); g.lda = 2048; g.Bt = (const bf16_t*)(p.ws + OFF_WOUT + l * SZ_WOUT1); g.ldb = 2048; g.M = (Mrows); g.N = 2048; g.K = 2048; \
            pg8::EpiRes e; float* xres = (float*)(p.ws + OFF_XRES); \
            e.xin0 = l == 0 ? p.in[0] : xres; e.xin1 = l == 0 ? p.in[1] - (size_t)TC * 2048 : xres; e.xo = xres; e.modl = (const float*)(p.ws + OFF_MOD) + (size_t)l * 5 * 6144; \
            pg8::StaticOrder S; S.init(g.M, g.N, (Gx), (cx), (pmo)); \
            pg8::gemm_phase<pg8::EpiRes>(lds, g, S, e); } while (0)
        RUNPH(pb + 5, { MK_MERGE_GEMM(8192, (int)gridDim.x, (int)blockIdx.x, 0); });
        RUNPH(pb + 6, { const int G = gridDim.x, bid = blockIdx.x, hg = G / 2;
            if (bid < hg) MK_MERGE_GEMM(4096, hg, bid, 32);
            else MK_OUT_GEMM(8192, G - hg, bid - hg, 0); });
        RUNPH(pb + 7, { const int G = gridDim.x, bid = blockIdx.x, hg = G / 2;
            if (bid < hg) MK_OUT_GEMM(4096, hg, bid, 32);
            else if (l == 0) phase_norm(p, 1, 0, TC, G - hg, bid - hg);
            else phase_final(p, 0, TC, G - hg, bid - hg); });
}

__global__ __launch_bounds__(512, 2) void mega(Params p_arg) {
    extern __shared__ __attribute__((aligned(16))) unsigned char shm0[];
    LAS unsigned char* lds0 = (LAS unsigned char*)shm0;
    cg::grid_group grid = cg::this_grid();
    const int ph_lo = p_arg.ph_lo, ph_hi = p_arg.ph_hi;
    if (ph_hi < 0) grid.sync();
    { volatile LAS unsigned* st = (volatile LAS unsigned*)(lds0 + 131072);
      if (threadIdx.x == 0) { st[0] = 0u; st[1] = 0u; st[2] = 0u; st[3] = 0u; }
      __syncthreads();
      if (threadIdx.x == 0) (void)xb_add(&((unsigned*)(p_arg.ws + OFF_BAR))[XB_XCNT(xb_xcc_id())], 1u); }
    RUNPH(0, phase_prep(p, shm););
    run_layer<0>(grid, lds0, ph_lo, ph_hi);
    run_layer<1>(grid, lds0, ph_lo, ph_hi);
    RUNPH(NPHASE - 1, phase_final(p, TC, T, (int)gridDim.x, (int)blockIdx.x););
}

#ifndef MK_PER_PHASE
#define MK_PER_PHASE 0
#endif

extern "C" void kernel_launch(void* const* d_in, const int* in_sizes, int n_in, void* d_out, int out_size, void* d_ws, size_t ws_size, hipStream_t stream) {
    static int grid = 0;
    if (grid == 0) {
        int dev = 0, cus = 0, per_cu = 0;
        hipGetDevice(&dev);
        hipDeviceGetAttribute(&cus, hipDeviceAttributeMultiprocessorCount, dev);
        if (hipFuncSetAttribute((const void*)mega, hipFuncAttributeMaxDynamicSharedMemorySize, LDS_BYTES) != hipSuccess) { fprintf(stderr, "hipFuncSetAttribute failed\n"); }
        if (hipOccupancyMaxActiveBlocksPerMultiprocessor(&per_cu, (const void*)mega, 512, LDS_BYTES) != hipSuccess || per_cu < 1) { fprintf(stderr, "occupancy query: %d\n", per_cu); per_cu = 1; }
        (void)hipGetLastError();
        grid = cus * 1;
        if (ws_size < WS_END) { fprintf(stderr, "workspace too small: %zu < %zu\n", ws_size, (size_t)WS_END); grid = -1; }
    }
    if (grid < 0) return;
    if (hipMemsetAsync((char*)d_ws + OFF_BAR, 0, BAR_BYTES, stream) != hipSuccess) { fprintf(stderr, "memset of barrier words failed\n"); return; }
    Params p{};
    for (int i = 0; i < 24; ++i) p.in[i] = (const float*)d_in[i];
    p.out = (float*)d_out; p.ws = (unsigned char*)d_ws;
#if MK_PER_PHASE
    for (int ph = 0; ph < NPHASE; ++ph) { p.ph_lo = ph; p.ph_hi = ph + 1; hipLaunchKernelGGL(mega, dim3(grid), dim3(512), LDS_BYTES, stream, p); }
#else
    p.ph_lo = 0; p.ph_hi = NPHASE;
    void* args[] = {&p};
    hipError_t e = hipLaunchCooperativeKernel((const void*)mega, dim3(grid), dim3(512), args, LDS_BYTES, stream);
    if (e != hipSuccess) fprintf(stderr, "cooperative launch failed: %s (grid %d)\n", hipGetErrorString(e), grid);
#endif
}
```
